# Optimizing an MI355X kernel written in HIP

```python
import math
import jax, jax.numpy as jnp
from jax import lax
import numpy as np

D_MODEL = 1024
BATCH = 4
SEQ = 4096
DEPTH = 1
DEC_BATCH = 128
DEC_SEQ = 4
PAST_LEN = 16384
PAGE_SIZE = 128

HG_HEADS = 4
HG_DK = 128
HG_DV = 128
HG_FWIDTH = HG_HEADS * HG_DK
HG_WIDTH = HG_HEADS * HG_DV
HG_CHUNK = 64
N_Q = 8
N_KV = 2
HEAD_DIM = 64
GROUP = N_Q // N_KV
WINDOW = 128
ROT_DIM = HEAD_DIM // 4
ROPE_THETA = 500000.0
SWA_WIDTH = N_Q * HEAD_DIM
D_FF = 4 * D_MODEL
EPS = 1e-6
NEG_INF = -1e30
IN_SPLITS = (HG_FWIDTH, HG_FWIDTH, HG_WIDTH, HG_WIDTH, SWA_WIDTH, N_KV * HEAD_DIM, N_KV * HEAD_DIM, D_MODEL, D_MODEL)
D_IN = sum(IN_SPLITS)

kernel_name = "hgrn2_swa_sink_gated_hybrid_step"


def _rmsnorm(x, w):
    xf = x.astype(jnp.float32)
    y = xf * lax.rsqrt(jnp.mean(xf * xf, axis=-1, keepdims=True) + EPS)
    return (y * w.astype(jnp.float32)).astype(x.dtype)


def _rotary(x, pos):
    half = ROT_DIM // 2
    inv = jnp.exp(-math.log(ROPE_THETA) * jnp.arange(half, dtype=jnp.float32) * (2.0 / ROT_DIM))
    ang = pos.astype(jnp.float32)[:, None] * inv[None, :]
    cos = jnp.cos(ang)[:, None, :].astype(x.dtype)
    sin = jnp.sin(ang)[:, None, :].astype(x.dtype)
    x1 = x[..., :half]
    x2 = x[..., half:ROT_DIM]
    return jnp.concatenate([x1 * cos - x2 * sin, x2 * cos + x1 * sin, x[..., ROT_DIM:]], axis=-1)


def _hgrn_recurrence(q, logf, k, v, s0, chunk):
    B, H, T, _ = q.shape
    n = T // chunk
    def blocks(t):
        return t.reshape(B, H, n, chunk, t.shape[-1]).transpose(2, 0, 1, 3, 4)
    causal = jnp.tril(jnp.ones((chunk, chunk), dtype=bool))[:, :, None]
    def step(S, inp):
        qc, lc, kc, vc = inp
        b = jnp.cumsum(lc, axis=-2)
        o_inter = jnp.einsum('bhcd,bhde->bhce', qc * jnp.exp(b), S)
        diff = b[..., :, None, :] - b[..., None, :, :]
        decay = jnp.exp(jnp.where(causal, diff, -jnp.inf))
        attn = jnp.einsum('bhtd,bhtsd,bhsd->bhts', qc, decay, kc)
        o_intra = jnp.einsum('bhts,bhse->bhte', attn, vc)
        bl = b[..., -1:, :]
        S_new = jnp.exp(bl[..., 0, :])[..., None] * S + jnp.einsum('bhsd,bhse->bhde', kc * jnp.exp(bl - b), vc)
        return S_new, o_inter + o_intra
    S, o = lax.scan(step, s0.astype(jnp.float32), (blocks(q), blocks(logf), blocks(k), blocks(v)))
    o = o.transpose(1, 2, 0, 3, 4).reshape(B, H, T, v.shape[-1])
    return o, S


def _sink_attention(q, k, v, mask, sinks):
    s = jnp.einsum('...qhgd,...khd->...hgqk', q.astype(jnp.float32), k.astype(jnp.float32)) * (HEAD_DIM ** -0.5)
    s = jnp.where(mask, s, NEG_INF)
    sink = jnp.broadcast_to(sinks.astype(jnp.float32).reshape(N_KV, GROUP, 1, 1), s.shape[:-1] + (1,))
    p = jax.nn.softmax(jnp.concatenate([s, sink], axis=-1), axis=-1)[..., :-1]
    return jnp.einsum('...hgqk,...khd->...qhgd', p.astype(v.dtype), v)


def _swa_prompt(q, k, v, sinks):
    B, T = q.shape[:2]
    nb = T // WINDOW
    qb = q.reshape(B, nb, WINDOW, N_KV, GROUP, HEAD_DIM)
    kb = k.reshape(B, nb, WINDOW, N_KV, HEAD_DIM)
    vb = v.reshape(B, nb, WINDOW, N_KV, HEAD_DIM)
    padw = ((0, 0), (1, 0), (0, 0), (0, 0), (0, 0))
    k2 = jnp.concatenate([jnp.pad(kb, padw)[:, :-1], kb], axis=2)
    v2 = jnp.concatenate([jnp.pad(vb, padw)[:, :-1], vb], axis=2)
    i = jnp.arange(WINDOW)[:, None]
    j = jnp.arange(2 * WINDOW)[None, :]
    rel = i + WINDOW - j
    kpos = (jnp.arange(nb)[:, None, None] - 1) * WINDOW + j[None]
    mask = (rel >= 0)[None] & (rel < WINDOW)[None] & (kpos >= 0)
    o = _sink_attention(qb, k2, v2, mask[:, None, None], sinks)
    return o.reshape(B, T, SWA_WIDTH)


def _swa_sample(q, k, v, ck, cv, sinks):
    Bd, Tn = q.shape[:2]
    wb = ck.shape[1]
    kall = jnp.concatenate([ck, k], axis=1)
    vall = jnp.concatenate([cv, v], axis=1)
    qpos = PAST_LEN + jnp.arange(Tn)
    kpos = PAST_LEN - wb + jnp.arange(wb + Tn)
    rel = qpos[:, None] - kpos[None, :]
    mask = (rel >= 0) & (rel < WINDOW)
    o = _sink_attention(q.reshape(Bd, Tn, N_KV, GROUP, HEAD_DIM), kall, vall, mask, sinks)
    return o.reshape(Bd, Tn, SWA_WIDTH), kall[:, -wb:], vall[:, -wb:]


def _layer(x, pos, ck, cv, s0, w_in, lb, hg_norm_w, sinks, w_up_a, w_up_b, w_o, n1, n2, w_ff1, w_ff2):
    B, T, _ = x.shape
    h = _rmsnorm(x, n1)
    z = h @ w_in
    hq, hf, hi, hg, sq, sk, sv, ga, gb = jnp.split(z, np.cumsum(IN_SPLITS)[:-1], axis=-1)
    f = lb + (1.0 - lb) * jax.nn.sigmoid(hf.astype(jnp.float32))
    def heads(t, d):
        return t.reshape(B, T, HG_HEADS, d).transpose(0, 2, 1, 3)
    o_hg, s_new = _hgrn_recurrence(heads(hq.astype(jnp.float32), HG_DK), heads(jnp.log(f), HG_DK),
                                   heads(1.0 - f, HG_DK), heads(hi.astype(jnp.float32), HG_DV),
                                   s0, math.gcd(T, HG_CHUNK))
    o_hg = _rmsnorm(o_hg.transpose(0, 2, 1, 3), hg_norm_w)
    y_a = (o_hg.reshape(B, T, HG_WIDTH).astype(x.dtype) * jax.nn.silu(hg)) @ w_up_a
    q = _rotary(sq.reshape(B, T, N_Q, HEAD_DIM), pos)
    k = _rotary(sk.reshape(B, T, N_KV, HEAD_DIM), pos)
    v = sv.reshape(B, T, N_KV, HEAD_DIM)
    if ck is None:
        o_b = _swa_prompt(q, k, v, sinks)
        nk, nv = k[:, -WINDOW:], v[:, -WINDOW:]
    else:
        o_b, nk, nv = _swa_sample(q, k, v, ck, cv, sinks)
    y_b = o_b @ w_up_b
    m = jax.nn.sigmoid(ga) * y_a + jax.nn.sigmoid(gb) * y_b
    x = x + m @ w_o
    h2 = _rmsnorm(x, n2)
    x = x + jnp.square(jax.nn.relu(h2 @ w_ff1)) @ w_ff2
    return x, nk, nv, s_new.astype(x.dtype)


def setup_inputs(seed: int = 0) -> dict:
    key = jax.random.key(seed)
    ks = jax.random.split(key, 18)
    f32 = jnp.float32
    wb = min(WINDOW, PAST_LEN)
    nrm = lambda k, s, sc: jax.random.normal(k, s, f32) * sc
    return {
        "x_prompt": nrm(ks[0], (BATCH, SEQ, D_MODEL), 1.0),
        "x_sample": nrm(ks[1], (DEC_BATCH, DEC_SEQ, D_MODEL), 1.0),
        "cache_swa_k": nrm(ks[2], (DEPTH, DEC_BATCH, wb, N_KV, HEAD_DIM), 1.0),
        "cache_swa_v": nrm(ks[3], (DEPTH, DEC_BATCH, wb, N_KV, HEAD_DIM), 1.0),
        "state_hgrn": nrm(ks[4], (DEPTH, DEC_BATCH, HG_HEADS, HG_DK, HG_DV), 0.3),
        "w_in": nrm(ks[5], (DEPTH, D_MODEL, D_IN), D_MODEL ** -0.5),
        "hgrn_lb_logits": nrm(ks[6], (DEPTH + 1, HG_FWIDTH), 0.5),
        "hgrn_norm_w": 1.0 + nrm(ks[7], (DEPTH, HG_HEADS, HG_DV), 0.02),
        "sinks": nrm(ks[8], (DEPTH, N_Q), 1.0),
        "w_up_a": nrm(ks[9], (DEPTH, HG_WIDTH, D_MODEL), HG_WIDTH ** -0.5),
        "w_up_b": nrm(ks[10], (DEPTH, SWA_WIDTH, D_MODEL), SWA_WIDTH ** -0.5),
        "w_o": nrm(ks[11], (DEPTH, D_MODEL, D_MODEL), D_MODEL ** -0.5),
        "norm1_w": 1.0 + nrm(ks[12], (DEPTH, D_MODEL), 0.02),
        "norm2_w": 1.0 + nrm(ks[13], (DEPTH, D_MODEL), 0.02),
        "w_ff1": nrm(ks[14], (DEPTH, D_MODEL, D_FF), D_MODEL ** -0.5),
        "w_ff2": nrm(ks[15], (DEPTH, D_FF, D_MODEL), D_FF ** -0.5),
        "normf_w": 1.0 + nrm(ks[16], (D_MODEL,), 0.02),
    }


def reference(x_prompt, x_sample, cache_swa_k, cache_swa_v, state_hgrn, w_in, hgrn_lb_logits, hgrn_norm_w,
              sinks, w_up_a, w_up_b, w_o, norm1_w, norm2_w, w_ff1, w_ff2, normf_w):
    lb_all = jnp.cumsum(jax.nn.softmax(hgrn_lb_logits.astype(jnp.float32), axis=0), axis=0)
    bp, tp = x_prompt.shape[:2]
    pos_p = jnp.arange(tp)
    pos_s = PAST_LEN + jnp.arange(x_sample.shape[1])
    xp, xs = x_prompt, x_sample
    kp_l, vp_l, sp_l, ks_l, vs_l, ss_l = [], [], [], [], [], []
    for l in range(DEPTH):
        wl = (w_in[l], lb_all[l], hgrn_norm_w[l], sinks[l], w_up_a[l], w_up_b[l], w_o[l],
              norm1_w[l], norm2_w[l], w_ff1[l], w_ff2[l])
        s0 = jnp.zeros((bp, HG_HEADS, HG_DK, HG_DV), jnp.float32)
        xp, kp, vp, sp = _layer(xp, pos_p, None, None, s0, *wl)
        xs, ksn, vsn, ssn = _layer(xs, pos_s, cache_swa_k[l], cache_swa_v[l], state_hgrn[l], *wl)
        kp_l.append(kp); vp_l.append(vp); sp_l.append(sp)
        ks_l.append(ksn); vs_l.append(vsn); ss_l.append(ssn)
    y_prompt = _rmsnorm(xp, normf_w)
    y_sample = _rmsnorm(xs, normf_w)
    return (y_prompt, y_sample, jnp.stack(kp_l), jnp.stack(vp_l), jnp.stack(sp_l),
            jnp.stack(ks_l), jnp.stack(vs_l), jnp.stack(ss_l))
```

```cpp
#include <hip/hip_runtime.h>
#include <cstdio>
#include <cstdint>

#ifndef MK_N_LAUNCHES
#define MK_N_LAUNCHES 1
#endif

#define LAS __attribute__((address_space(3)))
#define GAS __attribute__((address_space(1)))
typedef unsigned short bf16_t;
typedef short bf16x8 __attribute__((ext_vector_type(8)));
typedef short s16x4 __attribute__((ext_vector_type(4)));
typedef float f32x4 __attribute__((ext_vector_type(4)));
typedef float f32x2 __attribute__((ext_vector_type(2)));
typedef unsigned u32x4 __attribute__((ext_vector_type(4)));
typedef unsigned u32x2 __attribute__((ext_vector_type(2)));
typedef __bf16 bf16x2_t __attribute__((ext_vector_type(2)));

constexpr int DM = 1024, SEQ = 4096, NB = 4, MP = NB * SEQ  , DB = 128, DT = 4, MS = DB * DT  , M = MP + MS  ;
constexpr int PAST = 16384, DIN = 4864, DFF = 4096, WIN = 128;
constexpr float EPS = 1e-6f;
constexpr int NPHASE = 10;
constexpr int N_LAUNCHES = MK_N_LAUNCHES;

constexpr size_t O_Y = 0, O_NKP = (size_t)M * DM, O_NVP = O_NKP + 65536, O_NSP = O_NVP + 65536, O_NKS = O_NSP + 262144, O_NVS = O_NKS + 2097152, O_NSS = O_NVS + 2097152;

constexpr size_t MiB = 1u << 20;
constexpr size_t WS_CTL = 0, CTL_ZERO_BYTES = 1 * MiB;
constexpr size_t WS_WIN = 1 * MiB, WS_WUA = 11 * MiB, WS_WUB = 12 * MiB, WS_WO = 13 * MiB, WS_W1 = 15 * MiB, WS_W2 = 23 * MiB;
constexpr size_t WS_LB = 31 * MiB;
constexpr size_t WS_ROT = WS_LB + 4096;
constexpr size_t WS_GD = 31 * MiB + 512 * 1024;
constexpr size_t WS_SSQ1 = 32 * MiB;
constexpr size_t WS_SSQ2 = 33 * MiB + 128 * 1024;
constexpr size_t WS_XN = 35 * MiB;
constexpr size_t WS_LF = 68 * MiB;
constexpr size_t WS_BIG = 101 * MiB;
constexpr size_t SZ512 = (size_t)M * 512 * 2, SZ128 = (size_t)M * 128 * 2, SZ1024 = (size_t)M * 1024 * 2;
constexpr size_t WS_QH = WS_BIG, WS_VH = WS_QH + SZ512, WS_GH = WS_VH + SZ512, WS_SQ = WS_GH + SZ512, WS_SK = WS_SQ + SZ512, WS_SV = WS_SK + SZ128, WS_GA = WS_SV + SZ128, WS_GB = WS_GA + SZ1024;
constexpr size_t WS_HID = WS_BIG;
constexpr size_t WS_END = WS_GB + SZ1024;
static_assert(WS_ROT + (size_t)(SEQ + DT) * 64 <= WS_GD && WS_GD + 1024 * 128 * 4 <= WS_SSQ1, "ws map 1");
static_assert(WS_SSQ1 + (size_t)M * 64 <= WS_SSQ2 && WS_SSQ2 + (size_t)M * 64 <= WS_XN, "ws map 2");
static_assert(WS_XN + SZ1024 <= WS_LF && WS_LF + SZ1024 <= WS_BIG && WS_HID + (size_t)M * DFF * 2 <= WS_END && WS_END <= 256 * MiB, "ws map 3");
static_assert(WS_W2 + (size_t)DM * DFF * 2 <= WS_LB && WS_WIN + (size_t)DIN * DM * 2 <= WS_WUA, "ws map 4");

constexpr int CW_TMO = 0, CW_CODE = 1, CW_BAR = 4096;

__device__ __forceinline__ unsigned pk2(float lo, float hi) { f32x2 v = {lo, hi}; bf16x2_t b = __builtin_convertvector(v, bf16x2_t); return __builtin_bit_cast(unsigned, b); }
__device__ __forceinline__ float bflo(unsigned w) { return __uint_as_float(w << 16); }
__device__ __forceinline__ float bfhi(unsigned w) { return __uint_as_float(w & 0xffff0000u); }
__device__ __forceinline__ float bf2f(bf16_t h) { return __uint_as_float((unsigned)h << 16); }
__device__ __forceinline__ float sigmoidf_(float x) { return __builtin_amdgcn_rcpf(1.0f + __expf(-x)); }
#define MFMA16(a, b, c) __builtin_amdgcn_mfma_f32_16x16x32_bf16((a), (b), (c), 0, 0, 0)

namespace pg8 {
constexpr int BM = 256, BK = 64, HALF = 128, HTB = HALF * BK * 2, STAGE_BYTES = 8 * HTB, NXCD = 8, WGM = 8;
__host__ __device__ __forceinline__ int lds_byte(int r, int c) { const int st = (r >> 4) * 2 + (c >> 5), rr = r & 15, cc = c & 31, ob = rr * 64 + cc * 2; return st * 1024 + (ob ^ (((ob >> 9) & 1) << 5)); }
__host__ __device__ __forceinline__ void stage_rc(int b, int& R, int& C) { const int st = b / 1024, sb = b % 1024, swz = sb ^ (((sb >> 9) & 1) << 5); R = (st >> 1) * 16 + swz / 64; C = (st & 1) * 32 + (swz % 64) / 2; }
__host__ __device__ __forceinline__ int perm32(int rho) { const int n = rho >> 4, i = rho & 15; return 8 * (i >> 2) + 4 * n + (i & 3); }

struct Unit { int pm, pn, z; };
struct Gemm { const bf16_t* A0; const bf16_t* B0; const bf16_t* A1; const bf16_t* B1; int K; };

struct StaticOrder {
    int nM, nN, nwg, G, c, dual;
    __device__ void init(int M_, int N_, int G_, int c_, int dual_) { nM = M_ / BM; nN = N_ / BM; nwg = nM * nN; G = G_; c = c_; dual = dual_; }
    __device__ bool next(int i, Unit& u) const {
        const int idx = dual ? (i >> 1) : i; u.z = dual ? (i & 1) : 0;
        const long L = (long)idx * G + c; if (L >= nwg) return false;
        int wgid = (int)L; { const int q = nwg / NXCD, r = nwg % NXCD, xcd = wgid % NXCD, off = wgid / NXCD; wgid = (xcd < r ? xcd * (q + 1) : r * (q + 1) + (xcd - r) * q) + off; }
        const int nig = WGM * nN, gid = wgid / nig, fm = gid * WGM, gsz = (nM - fm) < WGM ? (nM - fm) : WGM;
        u.pm = fm + ((wgid % nig) % gsz); u.pn = (wgid % nig) / gsz; return true;
    }
};

template <class Epi>
__device__ __forceinline__ void gemm_phase(LAS unsigned char* lds, const Gemm g, const StaticOrder& S, const Epi& E) {
    const int tid = threadIdx.x, wid = __builtin_amdgcn_readfirstlane(tid >> 6), lane = tid & 63, wr = wid >> 2, wc = wid & 3, fr = lane & 15, fq = lane >> 4;
    const int K = g.K, nt = K / BK;
    unsigned voffA[2], voffB[2];
#pragma unroll
    for (int i = 0; i < 2; ++i) { int R, C; stage_rc(tid * 16 + i * 8192, R, C); const int Rb = (R & ~31) + perm32(R & 31);
        voffA[i] = (unsigned)(R * K + C) * 2u; voffB[i] = (unsigned)(Rb * K + C) * 2u; }
    const size_t kstep = (size_t)(BK * 2);
    const size_t hstep = (size_t)HALF * K * 2;
    const size_t tstep = 2 * hstep;
    const unsigned ldsw = (unsigned)wid * 1024u;
    const int aoff = lds_byte(wr * 64 + fr, fq * 8), boff = lds_byte(wc * 32 + fr, fq * 8);
#define PG8_SA(b, h) (((b) * 2 + (h)) * HTB)
#define PG8_SB(b, h) ((4 + (b) * 2 + (h)) * HTB)
#define PG8_STAGE(bufoff, gbase, voff) do { _Pragma("unroll") for (int _i = 0; _i < 2; ++_i) \
        __builtin_amdgcn_global_load_lds((const unsigned*)((const char*)(gbase) + (voff)[_i]), (LAS unsigned*)(lds + (bufoff) + ldsw + _i * 8192), 16, 0, 0); } while (0)
#define PG8_LDA(dst, b, h) do { _Pragma("unroll") for (int m = 0; m < 4; ++m) _Pragma("unroll") for (int k = 0; k < 2; ++k) dst[m][k] = *(const LAS bf16x8*)(lds + PG8_SA(b, h) + aoff + m * 2048 + k * 1024); } while (0)
#define PG8_LDB(dst, b, h) do { _Pragma("unroll") for (int n = 0; n < 2; ++n) _Pragma("unroll") for (int k = 0; k < 2; ++k) dst[n][k] = *(const LAS bf16x8*)(lds + PG8_SB(b, h) + boff + n * 2048 + k * 1024); } while (0)
#define PG8_MMA(ai, bj, At, Bt) do { __builtin_amdgcn_s_setprio(1); _Pragma("unroll") for (int m = 0; m < 4; ++m) _Pragma("unroll") for (int n = 0; n < 2; ++n) _Pragma("unroll") for (int k = 0; k < 2; ++k) \
        acc[ai][bj][m][n] = __builtin_amdgcn_mfma_f32_16x16x32_bf16(Bt[n][k], At[m][k], acc[ai][bj][m][n], 0, 0, 0); __builtin_amdgcn_s_setprio(0); } while (0)
#define PG8_WAIT_V(n) asm volatile("s_waitcnt vmcnt(" #n ")" ::: "memory")
#define PG8_WAIT_L(n) asm volatile("s_waitcnt lgkmcnt(" #n ")" ::: "memory")
#define PG8_BAR __builtin_amdgcn_s_barrier()
#define PG8_SCHED __builtin_amdgcn_sched_barrier(0)
    Unit cur, nxt; int ui = 0;
    if (!S.next(0, cur)) return;
    f32x4 acc[2][2][4][2];
#pragma unroll
    for (int a = 0; a < 2; ++a)
#pragma unroll
        for (int b = 0; b < 2; ++b)
#pragma unroll
            for (int m = 0; m < 4; ++m)
#pragma unroll
                for (int n = 0; n < 2; ++n) acc[a][b][m][n] = (f32x4){0.f, 0.f, 0.f, 0.f};
    bf16x8 At[4][2], B0[2][2], B1[2][2];
    const char* cA = (const char*)(cur.z ? g.A1 : g.A0) + (size_t)cur.pm * tstep; const char* cB = (const char*)(cur.z ? g.B1 : g.B0) + (size_t)cur.pn * tstep;
    PG8_STAGE(PG8_SB(0, 0), cB, voffB); PG8_STAGE(PG8_SB(0, 1), cB + hstep, voffB); PG8_STAGE(PG8_SA(0, 0), cA, voffA); PG8_STAGE(PG8_SA(0, 1), cA + hstep, voffA);
    if (wr == 1) PG8_BAR;
    PG8_WAIT_V(2); PG8_BAR;
    PG8_STAGE(PG8_SB(1, 0), cB + kstep, voffB); PG8_STAGE(PG8_SA(1, 0), cA + kstep, voffA); PG8_STAGE(PG8_SB(1, 1), cB + hstep + kstep, voffB);
    PG8_WAIT_V(6); PG8_BAR;
    for (;;) {
        const bool has_next = S.next(ui + 1, nxt);
        const char* nA = has_next ? (const char*)(nxt.z ? g.A1 : g.A0) + (size_t)nxt.pm * tstep : cA; const char* nB = has_next ? (const char*)(nxt.z ? g.B1 : g.B0) + (size_t)nxt.pn * tstep : cB;
        for (int t = 0; t < nt; t += 2) {
            const bool last = (t == nt - 2);
            const char* a1 = cA + (size_t)(t + 1) * kstep;
            const char* a2 = last ? nA : cA + (size_t)(t + 2) * kstep; const char* b2 = last ? nB : cB + (size_t)(t + 2) * kstep;
            const char* a3 = a2 + kstep; const char* b3 = b2 + kstep;
            PG8_LDB(B0, 0, 0); PG8_LDB(B1, 0, 1); PG8_SCHED; PG8_LDA(At, 0, 0); PG8_STAGE(PG8_SA(1, 1), a1 + hstep, voffA);
            PG8_WAIT_V(8); PG8_WAIT_L(0); PG8_BAR; PG8_MMA(0, 0, At, B0); PG8_MMA(0, 1, At, B1); PG8_BAR; PG8_SCHED;
            PG8_LDA(At, 0, 1); PG8_STAGE(PG8_SB(0, 0), b2, voffB); PG8_STAGE(PG8_SB(0, 1), b2 + hstep, voffB); PG8_STAGE(PG8_SA(0, 0), a2, voffA);
            PG8_WAIT_V(8); PG8_WAIT_L(0); PG8_BAR; PG8_MMA(1, 0, At, B0); PG8_MMA(1, 1, At, B1); PG8_BAR; PG8_SCHED;
            PG8_LDB(B0, 1, 0); PG8_LDB(B1, 1, 1); PG8_SCHED; PG8_LDA(At, 1, 0); PG8_STAGE(PG8_SA(0, 1), a2 + hstep, voffA);
            PG8_WAIT_V(8); PG8_WAIT_L(0); PG8_BAR; PG8_MMA(0, 0, At, B0); PG8_MMA(0, 1, At, B1); PG8_BAR; PG8_SCHED;
            PG8_LDA(At, 1, 1); PG8_STAGE(PG8_SB(1, 0), b3, voffB); PG8_STAGE(PG8_SB(1, 1), b3 + hstep, voffB); PG8_STAGE(PG8_SA(1, 0), a3, voffA);
            PG8_WAIT_V(8); PG8_WAIT_L(0); PG8_BAR; PG8_MMA(1, 0, At, B0); PG8_MMA(1, 1, At, B1); PG8_BAR; PG8_SCHED;
        }
        if (wr == 0) PG8_BAR;
        E(acc, cur, wr, wc, fr, fq);
        if (!has_next) break;
#pragma unroll
        for (int a = 0; a < 2; ++a)
#pragma unroll
            for (int b = 0; b < 2; ++b)
#pragma unroll
                for (int m = 0; m < 4; ++m)
#pragma unroll
                    for (int n = 0; n < 2; ++n) acc[a][b][m][n] = (f32x4){0.f, 0.f, 0.f, 0.f};
        cur = nxt; cA = nA; cB = nB; ++ui;
        if (wr == 1) PG8_BAR;
    }
    PG8_WAIT_V(0);
    PG8_BAR;
#undef PG8_SA
#undef PG8_SB
#undef PG8_STAGE
#undef PG8_LDA
#undef PG8_LDB
#undef PG8_MMA
#undef PG8_WAIT_V
#undef PG8_WAIT_L
#undef PG8_BAR
#undef PG8_SCHED
}
}

constexpr int RING_BYTES = 131072, LDSCTL_OFF = RING_BYTES, MISC_OFF = LDSCTL_OFF + 320, LDS_BYTES = 147456;
constexpr int NWAVES = 8;

typedef GAS unsigned gu32;
#define RLX_AGENT __ATOMIC_RELAXED, __HIP_MEMORY_SCOPE_AGENT
#define XB_TMO      128
#define XB_XCNT(j)  (256  + 64 * (j))
#define XB_XSUB(j)  (1280 + 64 * (j))
#define XB_XGEN(j)  (2304 + 64 * (j))
#define XB_TOP      3328
#define XB_TOPGEN   3392
#define XCD_BAR_WORDS 3456
#define XB_SPIN_CAP (1u << 18)
__device__ __forceinline__ unsigned xb_ld(unsigned* p)              { return __hip_atomic_load(p, __ATOMIC_RELAXED, __HIP_MEMORY_SCOPE_AGENT); }
__device__ __forceinline__ unsigned xb_add(unsigned* p, unsigned v) { return __hip_atomic_fetch_add(p, v, __ATOMIC_RELAXED, __HIP_MEMORY_SCOPE_AGENT); }
__device__ __forceinline__ unsigned xb_xcc_id() { return (unsigned)__builtin_amdgcn_s_getreg((3 << 11) | 20) & 0xFu; }
#define XB_SPIN(cond, bar) do { unsigned _sp = 0; while (cond) { __builtin_amdgcn_s_sleep(1); \
    if ((++_sp & 255u) == 0u) { if (xb_ld(&(bar)[XB_TMO])) break; if (_sp > XB_SPIN_CAP) { atomicAdd(&(bar)[XB_TMO], 1u); break; } } } } while (0)
struct XcdBarrier { unsigned* bar; unsigned x; volatile LAS unsigned* st; };
__device__ __forceinline__ XcdBarrier xcd_barrier_post(unsigned* bar, volatile LAS unsigned* st) {
    XcdBarrier b; b.bar = bar; b.x = xb_xcc_id(); b.st = st;
    if (threadIdx.x == 0) (void)xb_add(&bar[XB_XCNT(b.x)], 1u);
    return b;
}
__device__ __forceinline__ void xcd_barrier_complete(unsigned* bar, unsigned x, unsigned& nloc, unsigned& nx) {
    const unsigned G = gridDim.x * gridDim.y * gridDim.z;
    unsigned sum, cnt, mine, sp = 0u;
    for (;;) {
        sum = 0u; cnt = 0u; mine = 0u;
#pragma unroll
        for (unsigned j = 0; j < 16; ++j) { const unsigned c = xb_ld(&bar[XB_XCNT(j)]); sum += c; cnt += (c > 0u) ? 1u : 0u; mine = (j == x) ? c : mine; }
        if (sum == G) break;
        __builtin_amdgcn_s_sleep(1);
        if ((++sp & 255u) == 0u) { if (xb_ld(&bar[XB_TMO])) break; if (sp > XB_SPIN_CAP) { atomicAdd(&bar[XB_TMO], 1u); break; } }
    }
    nloc = mine > 0u ? mine : 1u; nx = cnt > 0u ? cnt : 1u;
}
__device__ __forceinline__ void xcd_barrier(const XcdBarrier& b) {
    asm volatile("s_waitcnt vmcnt(0)" ::: "memory");
    __syncthreads();
    if (threadIdx.x == 0) {
        unsigned* bar = b.bar;
        __builtin_amdgcn_s_waitcnt(0);
        unsigned nloc = b.st[0], nx = b.st[1];
        if (nloc == 0u) { xcd_barrier_complete(bar, b.x, nloc, nx); b.st[0] = nloc; b.st[1] = nx; }
        const unsigned old = xb_add(&bar[XB_XSUB(b.x)], 1u);
        const unsigned gen = old / nloc;
        if (old + 1u == (gen + 1u) * nloc) {
            __builtin_amdgcn_fence(__ATOMIC_RELEASE, "agent");
            asm volatile("s_waitcnt vmcnt(0)" ::: "memory");
            const unsigned og = xb_add(&bar[XB_TOP], 1u);
            const unsigned tg = og / nx;
            if (og + 1u == (tg + 1u) * nx) xb_add(&bar[XB_TOPGEN], 1u);
            else XB_SPIN(xb_ld(&bar[XB_TOPGEN]) == tg, bar);
            __builtin_amdgcn_fence(__ATOMIC_ACQUIRE, "agent");
            xb_add(&bar[XB_XGEN(b.x)], 1u);
            asm volatile("s_waitcnt vmcnt(0)" ::: "memory");
        } else {
            XB_SPIN(xb_ld(&bar[XB_XGEN(b.x)]) == gen, bar);
            __builtin_amdgcn_fence(__ATOMIC_ACQUIRE, "agent");
            asm volatile("s_waitcnt vmcnt(0)" ::: "memory");
        }
    }
    __syncthreads();
}

struct Frame {
    LAS unsigned char* lds;
    int tid, lane, wave, G, bid;
    const float *xp, *xs, *ck, *cv, *st, *w_in, *lbl, *hnw, *sinks, *w_ua, *w_ub, *w_o, *n1, *n2, *w_f1, *w_f2, *nf;
    float* out;
    bf16_t *Win_t, *Wua_t, *Wub_t, *Wo_t, *W1_t, *W2_t;
    float *LB, *GD, *SSQ1, *SSQ2, *LF; f32x2* ROT;
    bf16_t *XN, *DS, *MM, *X1B, *QH, *VH, *GH, *SQ, *SK, *SV, *GA, *GB, *HID;
};
__device__ __forceinline__ const float* xrow(const Frame& F, int row) { return row < MP ? F.xp + (size_t)row * DM : F.xs + (size_t)(row - MP) * DM; }
__device__ __forceinline__ int rot_index(int row) { return row < MP ? (row & (SEQ - 1)) : SEQ + (row & 3); }

__device__ __forceinline__ float wave_sum(float v) {
#pragma unroll
    for (int o = 1; o < 64; o <<= 1) v += __shfl_xor(v, o);
    return v;
}

__device__ __forceinline__ void p0_transpose_item(const float* W, int K, int N, bf16_t* WT, const float* ks, LAS float* scr, int item, int lane) {
    const int nblk = N / 32, kb = item / nblk, nb = item % nblk, k0 = 64 * kb, n0 = 32 * nb;
#pragma unroll 8
    for (int i = 0; i < 32; ++i) { const int kk = 2 * i + (lane >> 5); float w = W[(size_t)(k0 + kk) * N + n0 + (lane & 31)]; if (ks) w *= ks[k0 + kk]; scr[kk * 33 + (lane & 31)] = w; }
    asm volatile("s_waitcnt lgkmcnt(0)" ::: "memory");
    const int c = lane & 7;
#pragma unroll
    for (int j = 0; j < 4; ++j) { const int n = (lane >> 3) + 8 * j; const LAS float* s = scr + (8 * c) * 33 + n;
        u32x4 o; o.x = pk2(s[0 * 33], s[1 * 33]); o.y = pk2(s[2 * 33], s[3 * 33]); o.z = pk2(s[4 * 33], s[5 * 33]); o.w = pk2(s[6 * 33], s[7 * 33]);
        *(u32x4*)(WT + (size_t)(n0 + n) * K + k0 + 8 * c) = o; }
    asm volatile("s_waitcnt lgkmcnt(0)" ::: "memory");
}
__device__ __forceinline__ void p0_prologue(Frame& F) {
    LAS float* scr = (LAS float*)(F.lds + F.wave * 16384);
    const int gw = F.bid * NWAVES + F.wave, NGW = F.G * NWAVES;
    constexpr int I_IN = (DM / 64) * (DIN / 32), I_UA = (512 / 64) * (DM / 32), I_O = (DM / 64) * (DM / 32), I_1 = (DM / 64) * (DFF / 32), I_2 = (DFF / 64) * (DM / 32);
    constexpr int NITEMS = I_IN + 2 * I_UA + I_O + I_1 + I_2;
    for (int it = gw; it < NITEMS; it += NGW) {
        int r = it;
        if (r < I_IN) { p0_transpose_item(F.w_in, DM, DIN, F.Win_t, nullptr, scr, r, F.lane); continue; } r -= I_IN;
        if (r < I_UA) { p0_transpose_item(F.w_ua, 512, DM, F.Wua_t, nullptr, scr, r, F.lane); continue; } r -= I_UA;
        if (r < I_UA) { p0_transpose_item(F.w_ub, 512, DM, F.Wub_t, nullptr, scr, r, F.lane); continue; } r -= I_UA;
        if (r < I_O) { p0_transpose_item(F.w_o, DM, DM, F.Wo_t, nullptr, scr, r, F.lane); continue; } r -= I_O;
        if (r < I_1) { p0_transpose_item(F.w_f1, DM, DFF, F.W1_t, F.n2, scr, r, F.lane); continue; } r -= I_1;
        p0_transpose_item(F.w_f2, DFF, DM, F.W2_t, nullptr, scr, r, F.lane);
    }
    for (int m = gw; m < M; m += NGW) {
        const f32x4* xr = (const f32x4*)xrow(F, m) + F.lane; const f32x4* wn = (const f32x4*)F.n1 + F.lane;
        f32x4 v[4]; float s = 0.f;
#pragma unroll
        for (int j = 0; j < 4; ++j) { v[j] = xr[64 * j]; s += (v[j].x * v[j].x + v[j].y * v[j].y) + (v[j].z * v[j].z + v[j].w * v[j].w); }
        const float rstd = 1.0f / sqrtf(wave_sum(s) * (1.f / DM) + EPS);
        u32x2* o8 = (u32x2*)(F.XN + (size_t)m * DM) + F.lane;
#pragma unroll
        for (int j = 0; j < 4; ++j) { const f32x4 w = wn[64 * j]; u32x2 o; o.x = pk2(v[j].x * rstd * w.x, v[j].y * rstd * w.y); o.y = pk2(v[j].z * rstd * w.z, v[j].w * rstd * w.w); o8[64 * j] = o; }
    }
    const int gt = F.bid * (NWAVES * 64) + F.tid, NGT = F.G * NWAVES * 64;
    for (int i = gt; i < 512; i += NGT) { const float a = F.lbl[i], b = F.lbl[512 + i]; F.LB[i] = 1.0f / (1.0f + expf(b - a)); }
    for (int i = gt; i < (SEQ + DT) * 8; i += NGT) {
        const int pi = i >> 3, j = i & 7; const double pos = pi < SEQ ? (double)pi : (double)(PAST + (pi - SEQ));
        const double inv = exp(-13.122363377404328 * (double)j * 0.125);
        const double ang = pos * inv; F.ROT[i] = (f32x2){(float)cos(ang), (float)sin(ang)};
    }
}

using pg8::Unit;
struct EpiIn {
    bf16_t *QH, *VH, *GH, *SQ, *SK, *SV, *GA, *GB; float* LF; const float* LB; const f32x2* ROT;
    __device__ __forceinline__ void operator()(const f32x4 (&acc)[2][2][4][2], const Unit& u, int wr, int wc, int fr, int fq) const {
        const int pn = u.pn;
#pragma unroll
        for (int ai = 0; ai < 2; ++ai)
#pragma unroll
            for (int m = 0; m < 4; ++m) {
                const int row = u.pm * 256 + ai * 128 + wr * 64 + m * 16 + fr;
#pragma unroll
                for (int bj = 0; bj < 2; ++bj) {
                    const int col = pn * 256 + bj * 128 + wc * 32 + 8 * fq;
                    float v[8];
#pragma unroll
                    for (int j = 0; j < 4; ++j) { v[j] = acc[ai][bj][m][0][j]; v[4 + j] = acc[ai][bj][m][1][j]; }
                    bf16_t* dst = nullptr;
                    if (pn < 2) { dst = QH + (size_t)row * 512 + col; }
                    else if (pn < 4) {
                        const int c = col - 512; const f32x4 l0 = *(const f32x4*)(LB + c), l1 = *(const f32x4*)(LB + c + 4);
                        float lbv[8] = {l0.x, l0.y, l0.z, l0.w, l1.x, l1.y, l1.z, l1.w};
#pragma unroll
                        for (int j = 0; j < 8; ++j) v[j] = __logf(lbv[j] + (1.0f - lbv[j]) * sigmoidf_(v[j]));
                        float* d = LF + (size_t)row * 512 + c;
                        *(f32x4*)d = (f32x4){v[0], v[1], v[2], v[3]}; *(f32x4*)(d + 4) = (f32x4){v[4], v[5], v[6], v[7]};
                    }
                    else if (pn < 6) { dst = VH + (size_t)row * 512 + (col - 1024); }
                    else if (pn < 8) {
#pragma unroll
                        for (int j = 0; j < 8; ++j) v[j] = v[j] * sigmoidf_(v[j]);
                        dst = GH + (size_t)row * 512 + (col - 1536);
                    }
                    else if (pn < 11) {
                        const bool isv = (pn == 10 && bj == 1);
                        if (!isv && !(wc & 1)) {
                            const f32x2* rt = ROT + (size_t)rot_index(row) * 8;
                            float o[8];
#pragma unroll
                            for (int j = 0; j < 8; ++j) o[j] = __shfl_xor(v[j], 16);
                            if (fq < 2) {
#pragma unroll
                                for (int j = 0; j < 8; ++j) { const f32x2 cs = rt[j]; v[j] = (fq == 0) ? (v[j] * cs.x - o[j] * cs.y) : (v[j] * cs.x + o[j] * cs.y); }
                            }
                        }
                        if (pn < 10) dst = SQ + (size_t)row * 512 + (col - 2048);
                        else if (bj == 0) dst = SK + (size_t)row * 128 + (col - 2560);
                        else dst = SV + (size_t)row * 128 + (col - 2688);
                    }
                    else {
#pragma unroll
                        for (int j = 0; j < 8; ++j) v[j] = sigmoidf_(v[j]);
                        if (pn < 15) dst = GA + (size_t)row * 1024 + (col - 2816); else dst = GB + (size_t)row * 1024 + (col - 3840);
                    }
                    if (dst) { u32x4 w; w.x = pk2(v[0], v[1]); w.y = pk2(v[2], v[3]); w.z = pk2(v[4], v[5]); w.w = pk2(v[6], v[7]); *(u32x4*)dst = w; }
                }
            }
    }
};
struct EpiUp {
    bf16_t* MM; const bf16_t *GA, *GB;
    __device__ __forceinline__ void operator()(const f32x4 (&acc)[2][2][4][2], const Unit& u, int wr, int wc, int fr, int fq) const {
#pragma unroll
        for (int ai = 0; ai < 2; ++ai)
#pragma unroll
            for (int m = 0; m < 4; ++m) {
                const int row = u.pm * 256 + ai * 128 + wr * 64 + m * 16 + fr;
#pragma unroll
                for (int bj = 0; bj < 2; ++bj) {
                    const size_t off = (size_t)row * 1024 + u.pn * 256 + bj * 128 + wc * 32 + 8 * fq;
                    const u32x4 gt = *(const u32x4*)((u.z ? GB : GA) + off);
                    float v[8];
                    v[0] = acc[ai][bj][m][0][0] * bflo(gt.x); v[1] = acc[ai][bj][m][0][1] * bfhi(gt.x); v[2] = acc[ai][bj][m][0][2] * bflo(gt.y); v[3] = acc[ai][bj][m][0][3] * bfhi(gt.y);
                    v[4] = acc[ai][bj][m][1][0] * bflo(gt.z); v[5] = acc[ai][bj][m][1][1] * bfhi(gt.z); v[6] = acc[ai][bj][m][1][2] * bflo(gt.w); v[7] = acc[ai][bj][m][1][3] * bfhi(gt.w);
                    if (u.z) { const u32x4 p = *(const u32x4*)(MM + off);
                        v[0] += bflo(p.x); v[1] += bfhi(p.x); v[2] += bflo(p.y); v[3] += bfhi(p.y); v[4] += bflo(p.z); v[5] += bfhi(p.z); v[6] += bflo(p.w); v[7] += bfhi(p.w); }
                    u32x4 w; w.x = pk2(v[0], v[1]); w.y = pk2(v[2], v[3]); w.z = pk2(v[4], v[5]); w.w = pk2(v[6], v[7]); *(u32x4*)(MM + off) = w;
                }
            }
    }
};
struct EpiWo {
    const float *xp, *xs; float* out; bf16_t* X1B; float* SSQ;
    __device__ __forceinline__ void operator()(const f32x4 (&acc)[2][2][4][2], const Unit& u, int wr, int wc, int fr, int fq) const {
#pragma unroll
        for (int ai = 0; ai < 2; ++ai)
#pragma unroll
            for (int m = 0; m < 4; ++m) {
                const int row = u.pm * 256 + ai * 128 + wr * 64 + m * 16 + fr;
                const float* xr = row < MP ? xp + (size_t)row * DM : xs + (size_t)(row - MP) * DM;
                float ss = 0.f;
#pragma unroll
                for (int bj = 0; bj < 2; ++bj) {
                    const int col = u.pn * 256 + bj * 128 + wc * 32 + 8 * fq;
                    const f32x4 a = *(const f32x4*)(xr + col) + acc[ai][bj][m][0], b = *(const f32x4*)(xr + col + 4) + acc[ai][bj][m][1];
                    ss += (a.x * a.x + a.y * a.y) + (a.z * a.z + a.w * a.w) + (b.x * b.x + b.y * b.y) + (b.z * b.z + b.w * b.w);
                    float* o = out + (size_t)row * DM + col; *(f32x4*)o = a; *(f32x4*)(o + 4) = b;
                    u32x4 w; w.x = pk2(a.x, a.y); w.y = pk2(a.z, a.w); w.z = pk2(b.x, b.y); w.w = pk2(b.z, b.w); *(u32x4*)(X1B + (size_t)row * DM + col) = w;
                }
                ss += __shfl_xor(ss, 16); ss += __shfl_xor(ss, 32);
                if (fq == 0) SSQ[(size_t)row * 16 + u.pn * 4 + wc] = ss;
            }
    }
};
__device__ __forceinline__ float row_rstd(const float* SSQ, int row) {
    const f32x4* p = (const f32x4*)(SSQ + (size_t)row * 16); const f32x4 a = p[0], b = p[1], c = p[2], d = p[3];
    const float s = ((a.x + a.y) + (a.z + a.w)) + ((b.x + b.y) + (b.z + b.w)) + ((c.x + c.y) + (c.z + c.w)) + ((d.x + d.y) + (d.z + d.w));
    return 1.0f / sqrtf(s * (1.f / DM) + EPS);
}
struct EpiFf1 {
    bf16_t* HID; const float* SSQ;
    __device__ __forceinline__ void operator()(const f32x4 (&acc)[2][2][4][2], const Unit& u, int wr, int wc, int fr, int fq) const {
#pragma unroll
        for (int ai = 0; ai < 2; ++ai)
#pragma unroll
            for (int m = 0; m < 4; ++m) {
                const int row = u.pm * 256 + ai * 128 + wr * 64 + m * 16 + fr;
                const float rs = row_rstd(SSQ, row);
#pragma unroll
                for (int bj = 0; bj < 2; ++bj) {
                    float v[8];
#pragma unroll
                    for (int j = 0; j < 4; ++j) { v[j] = acc[ai][bj][m][0][j]; v[4 + j] = acc[ai][bj][m][1][j]; }
#pragma unroll
                    for (int j = 0; j < 8; ++j) { const float t = fmaxf(v[j] * rs, 0.f); v[j] = t * t; }
                    u32x4 w; w.x = pk2(v[0], v[1]); w.y = pk2(v[2], v[3]); w.z = pk2(v[4], v[5]); w.w = pk2(v[6], v[7]);
                    *(u32x4*)(HID + (size_t)row * DFF + u.pn * 256 + bj * 128 + wc * 32 + 8 * fq) = w;
                }
            }
    }
};
struct EpiFf2 {
    float* out; float* SSQ;
    __device__ __forceinline__ void operator()(const f32x4 (&acc)[2][2][4][2], const Unit& u, int wr, int wc, int fr, int fq) const {
#pragma unroll
        for (int ai = 0; ai < 2; ++ai)
#pragma unroll
            for (int m = 0; m < 4; ++m) {
                const int row = u.pm * 256 + ai * 128 + wr * 64 + m * 16 + fr;
                float ss = 0.f;
#pragma unroll
                for (int bj = 0; bj < 2; ++bj) {
                    float* o = out + (size_t)row * DM + u.pn * 256 + bj * 128 + wc * 32 + 8 * fq;
                    const f32x4 a = *(const f32x4*)o + acc[ai][bj][m][0], b = *(const f32x4*)(o + 4) + acc[ai][bj][m][1];
                    ss += (a.x * a.x + a.y * a.y) + (a.z * a.z + a.w * a.w) + (b.x * b.x + b.y * b.y) + (b.z * b.z + b.w * b.w);
                    *(f32x4*)o = a; *(f32x4*)(o + 4) = b;
                }
                ss += __shfl_xor(ss, 16); ss += __shfl_xor(ss, 32);
                if (fq == 0) SSQ[(size_t)row * 16 + u.pn * 4 + wc] = ss;
            }
    }
};

__device__ __forceinline__ void chunk_cumsum(const float* LFp  , LAS float* PART, int tq, int d, float (&lfv)[16], float (&cs)[16], float& pre, float& tot, float& mid) {
    const float* p = LFp + (size_t)(16 * tq) * 512 + d;
#pragma unroll
    for (int i = 0; i < 16; ++i) lfv[i] = p[(size_t)i * 512];
    float run = 0.f;
#pragma unroll
    for (int i = 0; i < 16; ++i) { run += lfv[i]; cs[i] = run; }
    PART[tq * 128 + d] = run;
    __syncthreads();
    const float p0 = PART[d], p1 = PART[128 + d], p2 = PART[256 + d], p3 = PART[384 + d];
    mid = p0 + p1; tot = (p0 + p1) + (p2 + p3);
    pre = tq == 0 ? 0.f : (tq == 1 ? p0 : (tq == 2 ? p0 + p1 : (p0 + p1) + p2));
}
__device__ __forceinline__ void fill_vt(const bf16_t* VHp  , LAS bf16_t* VT, int tid) {
    const int t = tid & 63, ech = tid >> 6;
    const u32x4* src = (const u32x4*)(VHp + (size_t)t * 512 + 16 * ech);
    const u32x4 a = src[0], b = src[1];
    const unsigned w[8] = {a.x, a.y, a.z, a.w, b.x, b.y, b.z, b.w};
#pragma unroll
    for (int j = 0; j < 8; ++j) { VT[(16 * ech + 2 * j) * 72 + t] = (bf16_t)(w[j] & 0xffffu); VT[(16 * ech + 2 * j + 1) * 72 + t] = (bf16_t)(w[j] >> 16); }
}

__device__ __forceinline__ void hgrn_pass1(Frame& F, int item) {
    const int tid = F.tid, lane = F.lane, w = F.wave, fr = lane & 15, fq = lane >> 4;
    const int bh = item >> 6, c = item & 63, b = bh >> 2, h = bh & 3, R0 = b * SEQ + c * 64;
    LAS float* PART = (LAS float*)F.lds; LAS bf16_t* KT = (LAS bf16_t*)(F.lds + 2048); LAS bf16_t* VT = (LAS bf16_t*)(F.lds + 2048 + 18432);
    const int tq = tid >> 7, d = tid & 127;
    float lfv[16], cs[16], pre, tot, mid;
    chunk_cumsum(F.LF + (size_t)R0 * 512 + h * 128, PART, tq, d, lfv, cs, pre, tot, mid);
    {
        unsigned pk[8];
#pragma unroll
        for (int i = 0; i < 8; ++i) {
            const float k0 = (1.0f - __expf(lfv[2 * i])) * __expf(tot - (pre + cs[2 * i])), k1 = (1.0f - __expf(lfv[2 * i + 1])) * __expf(tot - (pre + cs[2 * i + 1]));
            pk[i] = pk2(k0, k1);
        }
        LAS u32x4* dst = (LAS u32x4*)(KT + d * 72 + 16 * tq);
        dst[0] = (u32x4){pk[0], pk[1], pk[2], pk[3]}; dst[1] = (u32x4){pk[4], pk[5], pk[6], pk[7]};
        if (tq == 0) F.GD[(size_t)item * 128 + d] = __expf(tot);
    }
    fill_vt(F.VH + (size_t)R0 * 512 + h * 128, VT, tid);
    __syncthreads();
    bf16x8 a[2];
#pragma unroll
    for (int ks = 0; ks < 2; ++ks) a[ks] = *(const LAS bf16x8*)(KT + (16 * w + fr) * 72 + 32 * ks + 8 * fq);
    bf16_t* dsb = F.DS + (size_t)item * 16384;
#pragma unroll
    for (int et = 0; et < 8; ++et) {
        f32x4 acc = {0.f, 0.f, 0.f, 0.f};
#pragma unroll
        for (int ks = 0; ks < 2; ++ks) { const bf16x8 bb = *(const LAS bf16x8*)(VT + (16 * et + fr) * 72 + 32 * ks + 8 * fq); acc = MFMA16(a[ks], bb, acc); }
        u32x2 o; o.x = pk2(acc[0], acc[1]); o.y = pk2(acc[2], acc[3]);
        *(u32x2*)(dsb + (16 * et + fr) * 128 + 16 * w + 4 * fq) = o;
    }
    __syncthreads();
}

__device__ __forceinline__ void hgrn_pass2(Frame& F) {
    if (F.tid >= 128) return;
    const int gt = F.bid * 128 + F.tid;
    if (gt >= 16 * 128 * 16) return;
    const int bh = gt >> 11, rem = gt & 2047, e = rem >> 4, d8 = (rem & 15) * 8;
    float S[8];
#pragma unroll
    for (int i = 0; i < 8; ++i) S[i] = 0.f;
    for (int c = 0; c < 64; c += 4) {
        u32x4 dv[4]; f32x4 g0[4], g1[4];
#pragma unroll
        for (int k = 0; k < 4; ++k) {
            const size_t it = (size_t)bh * 64 + c + k;
            dv[k] = *(const u32x4*)(F.DS + it * 16384 + e * 128 + d8);
            g0[k] = *(const f32x4*)(F.GD + it * 128 + d8); g1[k] = *(const f32x4*)(F.GD + it * 128 + d8 + 4);
        }
#pragma unroll
        for (int k = 0; k < 4; ++k) {
            const size_t it = (size_t)bh * 64 + c + k;
            u32x4 o; o.x = pk2(S[0], S[1]); o.y = pk2(S[2], S[3]); o.z = pk2(S[4], S[5]); o.w = pk2(S[6], S[7]);
            *(u32x4*)(F.DS + it * 16384 + e * 128 + d8) = o;
            S[0] = g0[k].x * S[0] + bflo(dv[k].x); S[1] = g0[k].y * S[1] + bfhi(dv[k].x); S[2] = g0[k].z * S[2] + bflo(dv[k].y); S[3] = g0[k].w * S[3] + bfhi(dv[k].y);
            S[4] = g1[k].x * S[4] + bflo(dv[k].z); S[5] = g1[k].y * S[5] + bfhi(dv[k].z); S[6] = g1[k].z * S[6] + bflo(dv[k].w); S[7] = g1[k].w * S[7] + bfhi(dv[k].w);
        }
    }
    float* o = F.out + O_NSP + (size_t)bh * 16384 + (size_t)d8 * 128 + e;
#pragma unroll
    for (int i = 0; i < 8; ++i) o[(size_t)i * 128] = S[i];
}

__device__ __forceinline__ void hgrn_pass3(Frame& F, int item) {
    const int tid = F.tid, lane = F.lane, w = F.wave, fr = lane & 15, fq = lane >> 4;
    const int bh = item >> 6, c = item & 63, b = bh >> 2, h = bh & 3, R0 = b * SEQ + c * 64;
    LAS float* PART = (LAS float*)F.lds;
    LAS bf16_t* QI = (LAS bf16_t*)(F.lds + 2048); LAS bf16_t* QA = (LAS bf16_t*)(F.lds + 19456); LAS bf16_t* KA = (LAS bf16_t*)(F.lds + 36864);
    LAS bf16_t* VT = (LAS bf16_t*)(F.lds + 54272); LAS bf16_t* AT = (LAS bf16_t*)(F.lds + 72704); LAS float* RED = (LAS float*)(F.lds + 81920);
    const int tq = tid >> 7, d = tid & 127;
    float lfv[16], cs[16], pre, tot, mid;
    float qv[16];
    { const bf16_t* qp = F.QH + (size_t)(R0 + 16 * tq) * 512 + h * 128 + d;
#pragma unroll
      for (int i = 0; i < 16; ++i) qv[i] = bf2f(qp[(size_t)i * 512]); }
    chunk_cumsum(F.LF + (size_t)R0 * 512 + h * 128, PART, tq, d, lfv, cs, pre, tot, mid);
#pragma unroll
    for (int i = 0; i < 16; ++i) {
        const int t = 16 * tq + i; const float bb = pre + cs[i];
        const float qi = qv[i] * __expf(bb), qa = qv[i] * __expf(bb - mid), ka = (1.0f - __expf(lfv[i])) * __expf(mid - bb);
        QI[t * 136 + d] = (bf16_t)(pk2(qi, 0.f) & 0xffffu); QA[t * 136 + d] = (bf16_t)(pk2(qa, 0.f) & 0xffffu); KA[t * 136 + d] = (bf16_t)(pk2(ka, 0.f) & 0xffffu);
    }
    fill_vt(F.VH + (size_t)R0 * 512 + h * 128, VT, tid);
    __syncthreads();
    {
        const int tt = w & 3;
#pragma unroll
        for (int si = 0; si < 2; ++si) {
            const int st = 2 * (w >> 2) + si;
            f32x4 acc = {0.f, 0.f, 0.f, 0.f};
            if (st <= tt) {
#pragma unroll
                for (int ks = 0; ks < 4; ++ks) {
                    const bf16x8 aa = *(const LAS bf16x8*)(KA + (16 * st + fr) * 136 + 32 * ks + 8 * fq);
                    const bf16x8 bb = *(const LAS bf16x8*)(QA + (16 * tt + fr) * 136 + 32 * ks + 8 * fq);
                    acc = MFMA16(aa, bb, acc);
                }
            }
            const int t = 16 * tt + fr, s0 = 16 * st + 4 * fq;
            float p[4];
#pragma unroll
            for (int r = 0; r < 4; ++r) p[r] = (s0 + r <= t) ? acc[r] : 0.f;
            u32x2 o; o.x = pk2(p[0], p[1]); o.y = pk2(p[2], p[3]);
            *(LAS u32x2*)(AT + t * 72 + s0) = o;
        }
    }
    __syncthreads();
    f32x4 oacc[4];
#pragma unroll
    for (int tt = 0; tt < 4; ++tt) oacc[tt] = (f32x4){0.f, 0.f, 0.f, 0.f};
    {
        const bf16_t* sp = F.DS + (size_t)item * 16384 + (size_t)(16 * w + fr) * 128 + 8 * fq;
#pragma unroll
        for (int ks = 0; ks < 4; ++ks) {
            const bf16x8 aa = *(const bf16x8*)(sp + 32 * ks);
#pragma unroll
            for (int tt = 0; tt < 4; ++tt) { const bf16x8 bb = *(const LAS bf16x8*)(QI + (16 * tt + fr) * 136 + 32 * ks + 8 * fq); oacc[tt] = MFMA16(aa, bb, oacc[tt]); }
        }
#pragma unroll
        for (int ks = 0; ks < 2; ++ks) {
            const bf16x8 aa = *(const LAS bf16x8*)(VT + (16 * w + fr) * 72 + 32 * ks + 8 * fq);
#pragma unroll
            for (int tt = 0; tt < 4; ++tt) { const bf16x8 bb = *(const LAS bf16x8*)(AT + (16 * tt + fr) * 72 + 32 * ks + 8 * fq); oacc[tt] = MFMA16(aa, bb, oacc[tt]); }
        }
    }
#pragma unroll
    for (int tt = 0; tt < 4; ++tt) {
        float p = (oacc[tt][0] * oacc[tt][0] + oacc[tt][1] * oacc[tt][1]) + (oacc[tt][2] * oacc[tt][2] + oacc[tt][3] * oacc[tt][3]);
        p += __shfl_xor(p, 16); p += __shfl_xor(p, 32);
        if (fq == 0) RED[w * 64 + 16 * tt + fr] = p;
    }
    __syncthreads();
    {
        const int e0 = 16 * w + 4 * fq;
        const f32x4 hw = *(const f32x4*)(F.hnw + h * 128 + e0);
#pragma unroll
        for (int tt = 0; tt < 4; ++tt) {
            const int t = 16 * tt + fr;
            float s = 0.f;
#pragma unroll
            for (int ww = 0; ww < 8; ++ww) s += RED[ww * 64 + t];
            const float rs = 1.0f / sqrtf(s * (1.f / 128.f) + EPS);
            const size_t off = (size_t)(R0 + t) * 512 + h * 128 + e0;
            const u32x2 gg = *(const u32x2*)(F.GH + off);
            u32x2 o; o.x = pk2(oacc[tt][0] * rs * hw.x * bflo(gg.x), oacc[tt][1] * rs * hw.y * bfhi(gg.x)); o.y = pk2(oacc[tt][2] * rs * hw.z * bflo(gg.y), oacc[tt][3] * rs * hw.w * bfhi(gg.y));
            *(u32x2*)(F.QH + off) = o;
        }
    }
    __syncthreads();
}

__device__ __forceinline__ void swa_prompt(Frame& F, int item) {
    const int tid = F.tid, lane = F.lane, w = F.wave, fr = lane & 15, fq = lane >> 4;
    const int kvh = item & 1, nb = (item >> 1) & 31, b = item >> 6;
    LAS bf16_t* KS = (LAS bf16_t*)F.lds;
    LAS bf16_t* VT = (LAS bf16_t*)(F.lds + 36864);
    const int tok0 = nb * 128 - 128;
    {
        const int j = tid >> 1, half = tid & 1; const int tok = tok0 + j;
        u32x4 v0 = {0u, 0u, 0u, 0u}, v1 = v0, v2 = v0, v3 = v0;
        if (tok >= 0) { const u32x4* src = (const u32x4*)(F.SK + (size_t)(b * SEQ + tok) * 128 + kvh * 64 + 32 * half); v0 = src[0]; v1 = src[1]; v2 = src[2]; v3 = src[3]; }
        LAS u32x4* dst = (LAS u32x4*)(KS + j * 72 + 32 * half); dst[0] = v0; dst[1] = v1; dst[2] = v2; dst[3] = v3;
    }
    {
        const int j = tid & 255, half = tid >> 8; const int tok = tok0 + j;
        u32x4 v[4]; v[0] = (u32x4){0u, 0u, 0u, 0u}; v[1] = v[0]; v[2] = v[0]; v[3] = v[0];
        if (tok >= 0) { const u32x4* src = (const u32x4*)(F.SV + (size_t)(b * SEQ + tok) * 128 + kvh * 64 + 32 * half); v[0] = src[0]; v[1] = src[1]; v[2] = src[2]; v[3] = src[3]; }
#pragma unroll
        for (int q = 0; q < 4; ++q) {
            const unsigned ww[4] = {v[q].x, v[q].y, v[q].z, v[q].w};
#pragma unroll
            for (int k = 0; k < 4; ++k) { const int dd = 32 * half + 8 * q + 2 * k; VT[dd * 264 + j] = (bf16_t)(ww[k] & 0xffffu); VT[(dd + 1) * 264 + j] = (bf16_t)(ww[k] >> 16); }
        }
    }
    __syncthreads();
    if (nb == 31) {
        for (int i = tid; i < 128 * 64; i += 512) { const int jj = i >> 6, dd = i & 63; const size_t o = ((size_t)(b * 128 + jj) * 2 + kvh) * 64 + dd;
            F.out[O_NKP + o] = bf2f(KS[(128 + jj) * 72 + dd]); F.out[O_NVP + o] = bf2f(VT[dd * 264 + 128 + jj]); }
    }
    const int rowq = b * SEQ + nb * 128 + 16 * w + fr;
#pragma unroll 1
    for (int g = 0; g < 4; ++g) {
        const int head = 4 * kvh + g;
        bf16x8 qf[2];
#pragma unroll
        for (int ks = 0; ks < 2; ++ks) qf[ks] = *(const bf16x8*)(F.SQ + (size_t)rowq * 512 + head * 64 + 32 * ks + 8 * fq);
        f32x4 sc[9];
#pragma unroll
        for (int kt = 0; kt < 9; ++kt) {
            f32x4 acc = {0.f, 0.f, 0.f, 0.f};
#pragma unroll
            for (int ks = 0; ks < 2; ++ks) { const bf16x8 aa = *(const LAS bf16x8*)(KS + (16 * w + 16 * kt + fr) * 72 + 32 * ks + 8 * fq); acc = MFMA16(aa, qf[ks], acc); }
            sc[kt] = acc;
        }
        float mx = -1e30f;
#pragma unroll
        for (int kt = 0; kt < 9; ++kt)
#pragma unroll
            for (int r = 0; r < 4; ++r) {
                const int dj = 16 * kt + 4 * fq + r - fr, j = 16 * w + 16 * kt + 4 * fq + r;
                const bool ok = (dj >= 1) && (dj <= 128) && (nb > 0 || j >= 128);
                const float s = ok ? sc[kt][r] * 0.125f : -1e30f;
                sc[kt][r] = s; mx = fmaxf(mx, s);
            }
        mx = fmaxf(mx, __shfl_xor(mx, 16)); mx = fmaxf(mx, __shfl_xor(mx, 32));
        const float sink = F.sinks[head];
        mx = fmaxf(mx, sink);
        float sum = 0.f;
#pragma unroll
        for (int kt = 0; kt < 9; ++kt)
#pragma unroll
            for (int r = 0; r < 4; ++r) { const float p = __expf(sc[kt][r] - mx); sc[kt][r] = p; sum += p; }
        sum += __shfl_xor(sum, 16); sum += __shfl_xor(sum, 32);
        const float inv = 1.0f / (sum + __expf(sink - mx));
        bf16x8 pf[5];
#pragma unroll
        for (int p = 0; p < 5; ++p) {
            u32x4 wv;
            wv.x = pk2(sc[2 * p][0] * inv, sc[2 * p][1] * inv); wv.y = pk2(sc[2 * p][2] * inv, sc[2 * p][3] * inv);
            if (p < 4) { wv.z = pk2(sc[2 * p + 1][0] * inv, sc[2 * p + 1][1] * inv); wv.w = pk2(sc[2 * p + 1][2] * inv, sc[2 * p + 1][3] * inv); } else { wv.z = 0u; wv.w = 0u; }
            pf[p] = __builtin_bit_cast(bf16x8, wv);
        }
#pragma unroll
        for (int dt = 0; dt < 4; ++dt) {
            f32x4 acc = {0.f, 0.f, 0.f, 0.f};
#pragma unroll
            for (int p = 0; p < 5; ++p) {
                const LAS bf16_t* vp = VT + (16 * dt + fr) * 264 + 16 * w + 32 * p + 4 * fq;
                u32x4 av; const u32x2 lo = *(const LAS u32x2*)vp; av.x = lo.x; av.y = lo.y;
                if (p < 4) { const u32x2 hi = *(const LAS u32x2*)(vp + 16); av.z = hi.x; av.w = hi.y; } else { av.z = 0u; av.w = 0u; }
                acc = MFMA16(__builtin_bit_cast(bf16x8, av), pf[p], acc);
            }
            u32x2 o; o.x = pk2(acc[0], acc[1]); o.y = pk2(acc[2], acc[3]);
            *(u32x2*)(F.SQ + (size_t)rowq * 512 + head * 64 + 16 * dt + 4 * fq) = o;
        }
    }
    __syncthreads();
}

__device__ __forceinline__ void hgrn_sample(Frame& F, int item) {
    const int tid = F.tid, bs = item >> 2, h = item & 3;
    LAS float* RED = (LAS float*)F.lds;
    LAS float* RED2 = (LAS float*)(F.lds + 32768);
    const int e4 = tid & 31, dg = tid >> 5;
    const float* sp = F.st + ((size_t)item * 128 + 8 * dg) * 128 + 4 * e4;
    f32x4 S[8];
#pragma unroll
    for (int i = 0; i < 8; ++i) S[i] = *(const f32x4*)(sp + (size_t)i * 128);
#pragma unroll
    for (int t = 0; t < 4; ++t) {
        const size_t rb = (size_t)(MP + bs * 4 + t) * 512 + h * 128;
        const u32x2 vv = *(const u32x2*)(F.VH + rb + 4 * e4);
        const f32x4 v = {bflo(vv.x), bfhi(vv.x), bflo(vv.y), bfhi(vv.y)};
        const f32x4 l0 = *(const f32x4*)(F.LF + rb + 8 * dg), l1 = *(const f32x4*)(F.LF + rb + 8 * dg + 4);
        const u32x4 qq = *(const u32x4*)(F.QH + rb + 8 * dg);
        const float lf[8] = {l0.x, l0.y, l0.z, l0.w, l1.x, l1.y, l1.z, l1.w};
        const float q[8] = {bflo(qq.x), bfhi(qq.x), bflo(qq.y), bfhi(qq.y), bflo(qq.z), bfhi(qq.z), bflo(qq.w), bfhi(qq.w)};
        f32x4 po = {0.f, 0.f, 0.f, 0.f};
#pragma unroll
        for (int i = 0; i < 8; ++i) { const float f = __expf(lf[i]), k = 1.0f - f; S[i] = S[i] * f + v * k; po += S[i] * q[i]; }
        *(LAS f32x4*)(RED + (t * 16 + dg) * 128 + 4 * e4) = po;
    }
    float* op = F.out + O_NSS + ((size_t)item * 128 + 8 * dg) * 128 + 4 * e4;
#pragma unroll
    for (int i = 0; i < 8; ++i) *(f32x4*)(op + (size_t)i * 128) = S[i];
    __syncthreads();
    const int t = tid >> 7, e = tid & 127;
    float o = 0.f;
#pragma unroll
    for (int g = 0; g < 16; ++g) o += RED[(t * 16 + g) * 128 + e];
    const float ss = wave_sum(o * o);
    if (F.lane == 0) RED2[t * 2 + (F.wave & 1)] = ss;
    __syncthreads();
    const float rs = 1.0f / sqrtf((RED2[t * 2] + RED2[t * 2 + 1]) * (1.f / 128.f) + EPS);
    const size_t off = (size_t)(MP + bs * 4 + t) * 512 + h * 128 + e;
    F.QH[off] = (bf16_t)(pk2(o * rs * F.hnw[h * 128 + e] * bf2f(F.GH[off]), 0.f) & 0xffffu);
    __syncthreads();
}

__device__ __forceinline__ void swa_sample(Frame& F, int item) {
    const int tid = F.tid, lane = F.lane, w = F.wave, bs = item >> 1, kvh = item & 1;
    LAS float* Kf = (LAS float*)F.lds;
    LAS float* Vf = (LAS float*)(F.lds + 34560);
    LAS float* Qf = (LAS float*)(F.lds + 68352);
    LAS float* P = (LAS float*)(F.lds + 72512);
    for (int i = tid; i < 132 * 64; i += 512) {
        const int j = i >> 6, dd = i & 63; float kv, vv;
        if (j < 128) { const size_t o = ((size_t)(bs * 128 + j) * 2 + kvh) * 64 + dd; kv = F.ck[o]; vv = F.cv[o]; }
        else { const size_t o = (size_t)(MP + bs * 4 + (j - 128)) * 128 + kvh * 64 + dd; kv = bf2f(F.SK[o]); vv = bf2f(F.SV[o]); }
        Kf[j * 65 + dd] = kv; Vf[j * 64 + dd] = vv;
        if (j >= 4) { const size_t o = ((size_t)(bs * 128 + (j - 4)) * 2 + kvh) * 64 + dd; F.out[O_NKS + o] = kv; F.out[O_NVS + o] = vv; }
    }
    for (int i = tid; i < 16 * 64; i += 512) { const int qr = i >> 6, dd = i & 63, t = qr >> 2, g = qr & 3;
        Qf[qr * 65 + dd] = bf2f(F.SQ[(size_t)(MP + bs * 4 + t) * 512 + (4 * kvh + g) * 64 + dd]); }
    __syncthreads();
    {
        const int qr = tid & 15, jj = tid >> 4, t = qr >> 2;
#pragma unroll 1
        for (int m = 0; m < 5; ++m) {
            const int j = jj + 32 * m;
            if (j < 132) {
                float s = 0.f;
#pragma unroll 16
                for (int dd = 0; dd < 64; ++dd) s += Qf[qr * 65 + dd] * Kf[j * 65 + dd];
                const bool ok = (j >= t + 1) && (j <= t + 128);
                P[qr * 136 + j] = ok ? s * 0.125f : -1e30f;
            }
        }
    }
    __syncthreads();
    {
        const int qr = 2 * w + (lane >> 5), l32 = lane & 31;
        float sv[5]; float mx = -1e30f;
#pragma unroll
        for (int m = 0; m < 5; ++m) { const int j = l32 + 32 * m; sv[m] = (j < 132) ? P[qr * 136 + j] : -1e30f; mx = fmaxf(mx, sv[m]); }
#pragma unroll
        for (int o = 1; o < 32; o <<= 1) mx = fmaxf(mx, __shfl_xor(mx, o));
        const float sink = F.sinks[4 * kvh + (qr & 3)];
        mx = fmaxf(mx, sink);
        float sum = 0.f;
#pragma unroll
        for (int m = 0; m < 5; ++m) { sv[m] = __expf(sv[m] - mx); sum += sv[m]; }
#pragma unroll
        for (int o = 1; o < 32; o <<= 1) sum += __shfl_xor(sum, o);
        const float inv = 1.0f / (sum + __expf(sink - mx));
#pragma unroll
        for (int m = 0; m < 5; ++m) { const int j = l32 + 32 * m; if (j < 132) P[qr * 136 + j] = sv[m] * inv; }
    }
    __syncthreads();
    {
        const int qr = tid >> 5, d2 = (tid & 31) * 2, t = qr >> 2, g = qr & 3;
        float o0 = 0.f, o1 = 0.f;
#pragma unroll 4
        for (int j = 0; j < 132; ++j) { const float p = P[qr * 136 + j]; o0 += p * Vf[j * 64 + d2]; o1 += p * Vf[j * 64 + d2 + 1]; }
        *(unsigned*)(F.SQ + (size_t)(MP + bs * 4 + t) * 512 + (4 * kvh + g) * 64 + d2) = pk2(o0, o1);
    }
    __syncthreads();
}

__device__ __forceinline__ void final_norm(Frame& F) {
    const int gw = F.bid * NWAVES + F.wave, NGW = F.G * NWAVES;
    for (int m = gw; m < M; m += NGW) {
        const float rs = row_rstd(F.SSQ2, m);
        f32x4* xr = (f32x4*)(F.out + (size_t)m * DM) + F.lane; const f32x4* wn = (const f32x4*)F.nf + F.lane;
#pragma unroll
        for (int j = 0; j < 4; ++j) { const f32x4 v = xr[64 * j], wv = wn[64 * j]; xr[64 * j] = (f32x4){v.x * rs * wv.x, v.y * rs * wv.y, v.z * rs * wv.z, v.w * rs * wv.w}; }
    }
}

struct Args { const float* in[17]; float* out; unsigned char* ws; int ph_lo, ph_hi, li, pad; };
__global__ void __launch_bounds__(NWAVES * 64, 2) fwd(Args args) {
    extern __shared__ __attribute__((aligned(16))) unsigned char lds[];
    Frame F;
    F.lds = (LAS unsigned char*)lds;
    F.tid = threadIdx.x; F.lane = F.tid & 63; F.wave = __builtin_amdgcn_readfirstlane(F.tid >> 6); F.G = gridDim.x; F.bid = blockIdx.x;
    unsigned char* ws = args.ws;
    F.xp = args.in[0]; F.xs = args.in[1]; F.ck = args.in[2]; F.cv = args.in[3]; F.st = args.in[4]; F.w_in = args.in[5]; F.lbl = args.in[6]; F.hnw = args.in[7]; F.sinks = args.in[8];
    F.w_ua = args.in[9]; F.w_ub = args.in[10]; F.w_o = args.in[11]; F.n1 = args.in[12]; F.n2 = args.in[13]; F.w_f1 = args.in[14]; F.w_f2 = args.in[15]; F.nf = args.in[16];
    F.out = args.out;
    F.Win_t = (bf16_t*)(ws + WS_WIN); F.Wua_t = (bf16_t*)(ws + WS_WUA); F.Wub_t = (bf16_t*)(ws + WS_WUB); F.Wo_t = (bf16_t*)(ws + WS_WO); F.W1_t = (bf16_t*)(ws + WS_W1); F.W2_t = (bf16_t*)(ws + WS_W2);
    F.LB = (float*)(ws + WS_LB); F.ROT = (f32x2*)(ws + WS_ROT); F.GD = (float*)(ws + WS_GD); F.SSQ1 = (float*)(ws + WS_SSQ1); F.SSQ2 = (float*)(ws + WS_SSQ2); F.LF = (float*)(ws + WS_LF);
    F.XN = (bf16_t*)(ws + WS_XN); F.DS = (bf16_t*)(ws + WS_XN); F.MM = (bf16_t*)(ws + WS_XN); F.X1B = (bf16_t*)(ws + WS_LF);
    F.QH = (bf16_t*)(ws + WS_QH); F.VH = (bf16_t*)(ws + WS_VH); F.GH = (bf16_t*)(ws + WS_GH); F.SQ = (bf16_t*)(ws + WS_SQ); F.SK = (bf16_t*)(ws + WS_SK); F.SV = (bf16_t*)(ws + WS_SV);
    F.GA = (bf16_t*)(ws + WS_GA); F.GB = (bf16_t*)(ws + WS_GB); F.HID = (bf16_t*)(ws + WS_HID);
    for (int u = F.tid; u < (LDS_BYTES - LDSCTL_OFF) / 4; u += NWAVES * 64) ((LAS unsigned*)(F.lds + LDSCTL_OFF))[u] = 0u;
    __syncthreads();
    unsigned* ctl = (unsigned*)(ws + WS_CTL);
    XcdBarrier bar; bar.bar = ctl + CW_BAR; bar.x = 0; bar.st = nullptr;
    if (N_LAUNCHES == 1) bar = xcd_barrier_post(ctl + CW_BAR, (volatile LAS unsigned*)(F.lds + MISC_OFF) + 8);
    const int lo = args.ph_lo, hi = args.ph_hi;
#define IN(k) (lo <= (k) && (k) < hi)
#define SEAM(k) do { if (IN(k) && IN((k) + 1)) xcd_barrier(bar); } while (0)

    if (IN(0)) { p0_prologue(F); }
    SEAM(0);
    if (IN(1)) {
        pg8::Gemm g{F.XN, F.Win_t, F.XN, F.Win_t, DM}; pg8::StaticOrder S; S.init(M, DIN, F.G, F.bid, 0);
        EpiIn E{F.QH, F.VH, F.GH, F.SQ, F.SK, F.SV, F.GA, F.GB, F.LF, F.LB, F.ROT};
        pg8::gemm_phase<EpiIn>(F.lds, g, S, E);
    }
    SEAM(1);
    if (IN(2)) {
        for (int it = F.bid; it < 1024; it += F.G) hgrn_pass1(F, it);
        for (int it = F.bid; it < 256; it += F.G) swa_prompt(F, it);
        for (int it = F.bid; it < 512; it += F.G) hgrn_sample(F, it);
        for (int it = F.bid; it < 256; it += F.G) swa_sample(F, it);
    }
    SEAM(2);
    if (IN(3)) { hgrn_pass2(F); }
    SEAM(3);
    if (IN(4)) { for (int it = F.bid; it < 1024; it += F.G) hgrn_pass3(F, it); }
    SEAM(4);
    if (IN(5)) {
        pg8::Gemm g{F.QH, F.Wua_t, F.SQ, F.Wub_t, 512}; pg8::StaticOrder S; S.init(M, DM, F.G, F.bid, 1);
        EpiUp E{F.MM, F.GA, F.GB};
        pg8::gemm_phase<EpiUp>(F.lds, g, S, E);
    }
    SEAM(5);
    if (IN(6)) {
        pg8::Gemm g{F.MM, F.Wo_t, F.MM, F.Wo_t, DM}; pg8::StaticOrder S; S.init(M, DM, F.G, F.bid, 0);
        EpiWo E{F.xp, F.xs, F.out, F.X1B, F.SSQ1};
        pg8::gemm_phase<EpiWo>(F.lds, g, S, E);
    }
    SEAM(6);
    if (IN(7)) {
        pg8::Gemm g{F.X1B, F.W1_t, F.X1B, F.W1_t, DM}; pg8::StaticOrder S; S.init(M, DFF, F.G, F.bid, 0);
        EpiFf1 E{F.HID, F.SSQ1};
        pg8::gemm_phase<EpiFf1>(F.lds, g, S, E);
    }
    SEAM(7);
    if (IN(8)) {
        pg8::Gemm g{F.HID, F.W2_t, F.HID, F.W2_t, DFF}; pg8::StaticOrder S; S.init(M, DM, F.G, F.bid, 0);
        EpiFf2 E{F.out, F.SSQ2};
        pg8::gemm_phase<EpiFf2>(F.lds, g, S, E);
    }
    SEAM(8);
    if (IN(9)) { final_norm(F); }
#undef IN
#undef SEAM
}

extern "C" void kernel_launch(void* const* d_in, const int* in_sizes, int n_in, void* d_out, int out_size, void* d_ws, size_t ws_size, hipStream_t stream) {
    static int grid = 0;
    if (grid == 0) {
        if (n_in != 17 || in_sizes[0] != MP * DM || ws_size < WS_END) { fprintf(stderr, "kernel_launch: unexpected shapes (n_in %d, in0 %d, ws %zu); nothing launched\n", n_in, n_in > 0 ? in_sizes[0] : -1, ws_size); grid = -1; return; }
        int dev = 0, cus = 0, per_cu = 0;
        if (hipGetDevice(&dev) != hipSuccess || hipDeviceGetAttribute(&cus, hipDeviceAttributeMultiprocessorCount, dev) != hipSuccess) { grid = -1; return; }
        if (hipFuncSetAttribute((const void*)fwd, hipFuncAttributeMaxDynamicSharedMemorySize, LDS_BYTES) != hipSuccess) { fprintf(stderr, "kernel_launch: hipFuncSetAttribute failed\n"); grid = -1; return; }
        if (hipOccupancyMaxActiveBlocksPerMultiprocessor(&per_cu, (const void*)fwd, NWAVES * 64, LDS_BYTES) != hipSuccess || per_cu < 1) { fprintf(stderr, "kernel_launch: occupancy query says %d blocks per CU\n", per_cu); per_cu = 1; }
        (void)hipGetLastError();
        grid = cus;
    }
    if (grid < 0) return;
    (void)hipMemsetAsync((char*)d_ws + WS_CTL, 0, CTL_ZERO_BYTES, stream);
    Args a{};
    for (int i = 0; i < 17; ++i) a.in[i] = (const float*)d_in[i];
    a.out = (float*)d_out; a.ws = (unsigned char*)d_ws;
    if (N_LAUNCHES == 1) {
        a.ph_lo = 0; a.ph_hi = NPHASE; a.li = 0;
        hipLaunchKernelGGL(fwd, dim3(grid), dim3(NWAVES * 64), LDS_BYTES, stream, a);
    } else {
        for (int li = 0; li < NPHASE; ++li) { a.ph_lo = li; a.ph_hi = li + 1; a.li = li; hipLaunchKernelGGL(fwd, dim3(grid), dim3(NWAVES * 64), LDS_BYTES, stream, a); }
    }
}
```

```cpp
#include <hip/hip_runtime.h>
#include <cstdio>
#include <cstdint>

#ifndef MK_N_LAUNCHES
#define MK_N_LAUNCHES 1
#endif

#define LAS __attribute__((address_space(3)))
#define GAS __attribute__((address_space(1)))
typedef unsigned short bf16_t;
typedef short bf16x8 __attribute__((ext_vector_type(8)));
typedef short s16x4 __attribute__((ext_vector_type(4)));
typedef float f32x4 __attribute__((ext_vector_type(4)));
typedef float f32x2 __attribute__((ext_vector_type(2)));
typedef unsigned u32x4 __attribute__((ext_vector_type(4)));
typedef unsigned u32x2 __attribute__((ext_vector_type(2)));
typedef __bf16 bf16x2_t __attribute__((ext_vector_type(2)));

constexpr int DM = 1024, SEQ = 4096, NB = 4, MP = NB * SEQ  , DB = 128, DT = 4, MS = DB * DT  , M = MP + MS  ;
constexpr int PAST = 16384, DIN = 4864, DFF = 4096, WIN = 128;
constexpr float EPS = 1e-6f;
constexpr int NPHASE = 10;
constexpr int N_LAUNCHES = MK_N_LAUNCHES;

constexpr size_t O_Y = 0, O_NKP = (size_t)M * DM, O_NVP = O_NKP + 65536, O_NSP = O_NVP + 65536, O_NKS = O_NSP + 262144, O_NVS = O_NKS + 2097152, O_NSS = O_NVS + 2097152;

constexpr size_t MiB = 1u << 20;
constexpr size_t WS_CTL = 0, CTL_ZERO_BYTES = 1 * MiB;
constexpr size_t WS_WIN = 1 * MiB, WS_WUA = 11 * MiB, WS_WUB = 12 * MiB, WS_WO = 13 * MiB, WS_W1 = 15 * MiB, WS_W2 = 23 * MiB;
constexpr size_t WS_LB = 31 * MiB;
constexpr size_t WS_ROT = WS_LB + 4096;
constexpr size_t WS_GD = 31 * MiB + 512 * 1024;
constexpr size_t WS_SSQ1 = 32 * MiB;
constexpr size_t WS_SSQ2 = 33 * MiB + 128 * 1024;
constexpr size_t WS_XN = 35 * MiB;
constexpr size_t WS_LF = 68 * MiB;
constexpr size_t WS_BIG = 101 * MiB;
constexpr size_t SZ512 = (size_t)M * 512 * 2, SZ128 = (size_t)M * 128 * 2, SZ1024 = (size_t)M * 1024 * 2;
constexpr size_t WS_QH = WS_BIG, WS_VH = WS_QH + SZ512, WS_GH = WS_VH + SZ512, WS_SQ = WS_GH + SZ512, WS_SK = WS_SQ + SZ512, WS_SV = WS_SK + SZ128, WS_GA = WS_SV + SZ128, WS_GB = WS_GA + SZ1024;
constexpr size_t WS_HID = WS_BIG;
constexpr size_t WS_END = WS_GB + SZ1024;
static_assert(WS_ROT + (size_t)(SEQ + DT) * 64 <= WS_GD && WS_GD + 1024 * 128 * 4 <= WS_SSQ1, "ws map 1");
static_assert(WS_SSQ1 + (size_t)M * 64 <= WS_SSQ2 && WS_SSQ2 + (size_t)M * 64 <= WS_XN, "ws map 2");
static_assert(WS_XN + SZ1024 <= WS_LF && WS_LF + SZ1024 <= WS_BIG && WS_HID + (size_t)M * DFF * 2 <= WS_END && WS_END <= 256 * MiB, "ws map 3");
static_assert(WS_W2 + (size_t)DM * DFF * 2 <= WS_LB && WS_WIN + (size_t)DIN * DM * 2 <= WS_WUA, "ws map 4");

constexpr int CW_TMO = 0, CW_CODE = 1, CW_BAR = 4096;

__device__ __forceinline__ unsigned pk2(float lo, float hi) { f32x2 v = {lo, hi}; bf16x2_t b = __builtin_convertvector(v, bf16x2_t); return __builtin_bit_cast(unsigned, b); }
__device__ __forceinline__ float bflo(unsigned w) { return __uint_as_float(w << 16); }
__device__ __forceinline__ float bfhi(unsigned w) { return __uint_as_float(w & 0xffff0000u); }
__device__ __forceinline__ float bf2f(bf16_t h) { return __uint_as_float((unsigned)h << 16); }
__device__ __forceinline__ float sigmoidf_(float x) { return __builtin_amdgcn_rcpf(1.0f + __expf(-x)); }
#define MFMA16(a, b, c) __builtin_amdgcn_mfma_f32_16x16x32_bf16((a), (b), (c), 0, 0, 0)

namespace pg8 {
constexpr int BM = 256, BK = 64, HALF = 128, HTB = HALF * BK * 2, STAGE_BYTES = 8 * HTB, NXCD = 8, WGM = 8;
__host__ __device__ __forceinline__ int lds_byte(int r, int c) { const int st = (r >> 4) * 2 + (c >> 5), rr = r & 15, cc = c & 31, ob = rr * 64 + cc * 2; return st * 1024 + (ob ^ (((ob >> 9) & 1) << 5)); }
__host__ __device__ __forceinline__ void stage_rc(int b, int& R, int& C) { const int st = b / 1024, sb = b % 1024, swz = sb ^ (((sb >> 9) & 1) << 5); R = (st >> 1) * 16 + swz / 64; C = (st & 1) * 32 + (swz % 64) / 2; }
__host__ __device__ __forceinline__ int perm32(int rho) { const int n = rho >> 4, i = rho & 15; return 8 * (i >> 2) + 4 * n + (i & 3); }

struct Unit { int pm, pn, z; };
struct Gemm { const bf16_t* A0; const bf16_t* B0; const bf16_t* A1; const bf16_t* B1; int K; };

struct StaticOrder {
    int nM, nN, nwg, G, c, dual;
    __device__ void init(int M_, int N_, int G_, int c_, int dual_) { nM = M_ / BM; nN = N_ / BM; nwg = nM * nN; G = G_; c = c_; dual = dual_; }
    __device__ bool next(int i, Unit& u) const {
        const int idx = dual ? (i >> 1) : i; u.z = dual ? (i & 1) : 0;
        const long L = (long)idx * G + c; if (L >= nwg) return false;
        int wgid = (int)L; { const int q = nwg / NXCD, r = nwg % NXCD, xcd = wgid % NXCD, off = wgid / NXCD; wgid = (xcd < r ? xcd * (q + 1) : r * (q + 1) + (xcd - r) * q) + off; }
        const int nig = WGM * nN, gid = wgid / nig, fm = gid * WGM, gsz = (nM - fm) < WGM ? (nM - fm) : WGM;
        u.pm = fm + ((wgid % nig) % gsz); u.pn = (wgid % nig) / gsz; return true;
    }
};

template <class Epi>
__device__ __forceinline__ void gemm_phase(LAS unsigned char* lds, const Gemm g, const StaticOrder& S, const Epi& E) {
    const int tid = threadIdx.x, wid = __builtin_amdgcn_readfirstlane(tid >> 6), lane = tid & 63, wr = wid >> 2, wc = wid & 3, fr = lane & 15, fq = lane >> 4;
    const int K = g.K, nt = K / BK;
    unsigned voffA[2], voffB[2];
#pragma unroll
    for (int i = 0; i < 2; ++i) { int R, C; stage_rc(tid * 16 + i * 8192, R, C); const int Rb = (R & ~31) + perm32(R & 31);
        voffA[i] = (unsigned)(R * K + C) * 2u; voffB[i] = (unsigned)(Rb * K + C) * 2u; }
    const size_t kstep = (size_t)(BK * 2);
    const size_t hstep = (size_t)HALF * K * 2;
    const size_t tstep = 2 * hstep;
    const unsigned ldsw = (unsigned)wid * 1024u;
    const int aoff = lds_byte(wr * 64 + fr, fq * 8), boff = lds_byte(wc * 32 + fr, fq * 8);
#define PG8_SA(b, h) (((b) * 2 + (h)) * HTB)
#define PG8_SB(b, h) ((4 + (b) * 2 + (h)) * HTB)
#define PG8_STAGE(bufoff, gbase, voff) do { _Pragma("unroll") for (int _i = 0; _i < 2; ++_i) \
        __builtin_amdgcn_global_load_lds((const unsigned*)((const char*)(gbase) + (voff)[_i]), (LAS unsigned*)(lds + (bufoff) + ldsw + _i * 8192), 16, 0, 0); } while (0)
#define PG8_LDA(dst, b, h) do { _Pragma("unroll") for (int m = 0; m < 4; ++m) _Pragma("unroll") for (int k = 0; k < 2; ++k) dst[m][k] = *(const LAS bf16x8*)(lds + PG8_SA(b, h) + aoff + m * 2048 + k * 1024); } while (0)
#define PG8_LDB(dst, b, h) do { _Pragma("unroll") for (int n = 0; n < 2; ++n) _Pragma("unroll") for (int k = 0; k < 2; ++k) dst[n][k] = *(const LAS bf16x8*)(lds + PG8_SB(b, h) + boff + n * 2048 + k * 1024); } while (0)
#define PG8_MMA(ai, bj, At, Bt) do { __builtin_amdgcn_s_setprio(1); _Pragma("unroll") for (int m = 0; m < 4; ++m) _Pragma("unroll") for (int n = 0; n < 2; ++n) _Pragma("unroll") for (int k = 0; k < 2; ++k) \
        acc[ai][bj][m][n] = __builtin_amdgcn_mfma_f32_16x16x32_bf16(Bt[n][k], At[m][k], acc[ai][bj][m][n], 0, 0, 0); __builtin_amdgcn_s_setprio(0); } while (0)
#define PG8_WAIT_V(n) asm volatile("s_waitcnt vmcnt(" #n ")" ::: "memory")
#define PG8_WAIT_L(n) asm volatile("s_waitcnt lgkmcnt(" #n ")" ::: "memory")
#define PG8_BAR __builtin_amdgcn_s_barrier()
#define PG8_SCHED __builtin_amdgcn_sched_barrier(0)
    Unit cur, nxt; int ui = 0;
    if (!S.next(0, cur)) return;
    f32x4 acc[2][2][4][2];
#pragma unroll
    for (int a = 0; a < 2; ++a)
#pragma unroll
        for (int b = 0; b < 2; ++b)
#pragma unroll
            for (int m = 0; m < 4; ++m)
#pragma unroll
                for (int n = 0; n < 2; ++n) acc[a][b][m][n] = (f32x4){0.f, 0.f, 0.f, 0.f};
    bf16x8 At[4][2], B0[2][2], B1[2][2];
    const char* cA = (const char*)(cur.z ? g.A1 : g.A0) + (size_t)cur.pm * tstep; const char* cB = (const char*)(cur.z ? g.B1 : g.B0) + (size_t)cur.pn * tstep;
    PG8_STAGE(PG8_SB(0, 0), cB, voffB); PG8_STAGE(PG8_SB(0, 1), cB + hstep, voffB); PG8_STAGE(PG8_SA(0, 0), cA, voffA); PG8_STAGE(PG8_SA(0, 1), cA + hstep, voffA);
    if (wr == 1) PG8_BAR;
    PG8_WAIT_V(2); PG8_BAR;
    PG8_STAGE(PG8_SB(1, 0), cB + kstep, voffB); PG8_STAGE(PG8_SA(1, 0), cA + kstep, voffA); PG8_STAGE(PG8_SB(1, 1), cB + hstep + kstep, voffB);
    PG8_WAIT_V(6); PG8_BAR;
    for (;;) {
        const bool has_next = S.next(ui + 1, nxt);
        const char* nA = has_next ? (const char*)(nxt.z ? g.A1 : g.A0) + (size_t)nxt.pm * tstep : cA; const char* nB = has_next ? (const char*)(nxt.z ? g.B1 : g.B0) + (size_t)nxt.pn * tstep : cB;
        for (int t = 0; t < nt; t += 2) {
            const bool last = (t == nt - 2);
            const char* a1 = cA + (size_t)(t + 1) * kstep;
            const char* a2 = last ? nA : cA + (size_t)(t + 2) * kstep; const char* b2 = last ? nB : cB + (size_t)(t + 2) * kstep;
            const char* a3 = a2 + kstep; const char* b3 = b2 + kstep;
            PG8_LDB(B0, 0, 0); PG8_LDB(B1, 0, 1); PG8_SCHED; PG8_LDA(At, 0, 0); PG8_STAGE(PG8_SA(1, 1), a1 + hstep, voffA);
            PG8_WAIT_V(8); PG8_WAIT_L(0); PG8_BAR; PG8_MMA(0, 0, At, B0); PG8_MMA(0, 1, At, B1); PG8_BAR; PG8_SCHED;
            PG8_LDA(At, 0, 1); PG8_STAGE(PG8_SB(0, 0), b2, voffB); PG8_STAGE(PG8_SB(0, 1), b2 + hstep, voffB); PG8_STAGE(PG8_SA(0, 0), a2, voffA);
            PG8_WAIT_V(8); PG8_WAIT_L(0); PG8_BAR; PG8_MMA(1, 0, At, B0); PG8_MMA(1, 1, At, B1); PG8_BAR; PG8_SCHED;
            PG8_LDB(B0, 1, 0); PG8_LDB(B1, 1, 1); PG8_SCHED; PG8_LDA(At, 1, 0); PG8_STAGE(PG8_SA(0, 1), a2 + hstep, voffA);
            PG8_WAIT_V(8); PG8_WAIT_L(0); PG8_BAR; PG8_MMA(0, 0, At, B0); PG8_MMA(0, 1, At, B1); PG8_BAR; PG8_SCHED;
            PG8_LDA(At, 1, 1); PG8_STAGE(PG8_SB(1, 0), b3, voffB); PG8_STAGE(PG8_SB(1, 1), b3 + hstep, voffB); PG8_STAGE(PG8_SA(1, 0), a3, voffA);
            PG8_WAIT_V(8); PG8_WAIT_L(0); PG8_BAR; PG8_MMA(1, 0, At, B0); PG8_MMA(1, 1, At, B1); PG8_BAR; PG8_SCHED;
        }
        if (wr == 0) PG8_BAR;
        E(acc, cur, wr, wc, fr, fq);
        if (!has_next) break;
#pragma unroll
        for (int a = 0; a < 2; ++a)
#pragma unroll
            for (int b = 0; b < 2; ++b)
#pragma unroll
                for (int m = 0; m < 4; ++m)
#pragma unroll
                    for (int n = 0; n < 2; ++n) acc[a][b][m][n] = (f32x4){0.f, 0.f, 0.f, 0.f};
        cur = nxt; cA = nA; cB = nB; ++ui;
        if (wr == 1) PG8_BAR;
    }
    PG8_WAIT_V(0);
    PG8_BAR;
#undef PG8_SA
#undef PG8_SB
#undef PG8_STAGE
#undef PG8_LDA
#undef PG8_LDB
#undef PG8_MMA
#undef PG8_WAIT_V
#undef PG8_WAIT_L
#undef PG8_BAR
#undef PG8_SCHED
}
}

constexpr int RING_BYTES = 131072, LDSCTL_OFF = RING_BYTES, MISC_OFF = LDSCTL_OFF + 320, LDS_BYTES = 147456;
constexpr int NWAVES = 8;

typedef GAS unsigned gu32;
#define RLX_AGENT __ATOMIC_RELAXED, __HIP_MEMORY_SCOPE_AGENT
#define XB_TMO      128
#define XB_XCNT(j)  (256  + 64 * (j))
#define XB_XSUB(j)  (1280 + 64 * (j))
#define XB_XGEN(j)  (2304 + 64 * (j))
#define XB_TOP      3328
#define XB_TOPGEN   3392
#define XCD_BAR_WORDS 3456
#define XB_SPIN_CAP (1u << 18)
__device__ __forceinline__ unsigned xb_ld(unsigned* p)              { return __hip_atomic_load(p, __ATOMIC_RELAXED, __HIP_MEMORY_SCOPE_AGENT); }
__device__ __forceinline__ unsigned xb_add(unsigned* p, unsigned v) { return __hip_atomic_fetch_add(p, v, __ATOMIC_RELAXED, __HIP_MEMORY_SCOPE_AGENT); }
__device__ __forceinline__ unsigned xb_xcc_id() { return (unsigned)__builtin_amdgcn_s_getreg((3 << 11) | 20) & 0xFu; }
#define XB_SPIN(cond, bar) do { unsigned _sp = 0; while (cond) { __builtin_amdgcn_s_sleep(1); \
    if ((++_sp & 255u) == 0u) { if (xb_ld(&(bar)[XB_TMO])) break; if (_sp > XB_SPIN_CAP) { atomicAdd(&(bar)[XB_TMO], 1u); break; } } } } while (0)
struct XcdBarrier { unsigned* bar; unsigned x; volatile LAS unsigned* st; };
__device__ __forceinline__ XcdBarrier xcd_barrier_post(unsigned* bar, volatile LAS unsigned* st) {
    XcdBarrier b; b.bar = bar; b.x = xb_xcc_id(); b.st = st;
    if (threadIdx.x == 0) (void)xb_add(&bar[XB_XCNT(b.x)], 1u);
    return b;
}
__device__ __forceinline__ void xcd_barrier_complete(unsigned* bar, unsigned x, unsigned& nloc, unsigned& nx) {
    const unsigned G = gridDim.x * gridDim.y * gridDim.z;
    unsigned sum, cnt, mine, sp = 0u;
    for (;;) {
        sum = 0u; cnt = 0u; mine = 0u;
#pragma unroll
        for (unsigned j = 0; j < 16; ++j) { const unsigned c = xb_ld(&bar[XB_XCNT(j)]); sum += c; cnt += (c > 0u) ? 1u : 0u; mine = (j == x) ? c : mine; }
        if (sum == G) break;
        __builtin_amdgcn_s_sleep(1);
        if ((++sp & 255u) == 0u) { if (xb_ld(&bar[XB_TMO])) break; if (sp > XB_SPIN_CAP) { atomicAdd(&bar[XB_TMO], 1u); break; } }
    }
    nloc = mine > 0u ? mine : 1u; nx = cnt > 0u ? cnt : 1u;
}
__device__ __forceinline__ void xcd_barrier(const XcdBarrier& b) {
    asm volatile("s_waitcnt vmcnt(0)" ::: "memory");
    __syncthreads();
    if (threadIdx.x == 0) {
        unsigned* bar = b.bar;
        __builtin_amdgcn_s_waitcnt(0);
        unsigned nloc = b.st[0], nx = b.st[1];
        if (nloc == 0u) { xcd_barrier_complete(bar, b.x, nloc, nx); b.st[0] = nloc; b.st[1] = nx; }
        const unsigned old = xb_add(&bar[XB_XSUB(b.x)], 1u);
        const unsigned gen = old / nloc;
        if (old + 1u == (gen + 1u) * nloc) {
            __builtin_amdgcn_fence(__ATOMIC_RELEASE, "agent");
            asm volatile("s_waitcnt vmcnt(0)" ::: "memory");
            const unsigned og = xb_add(&bar[XB_TOP], 1u);
            const unsigned tg = og / nx;
            if (og + 1u == (tg + 1u) * nx) xb_add(&bar[XB_TOPGEN], 1u);
            else XB_SPIN(xb_ld(&bar[XB_TOPGEN]) == tg, bar);
            __builtin_amdgcn_fence(__ATOMIC_ACQUIRE, "agent");
            xb_add(&bar[XB_XGEN(b.x)], 1u);
            asm volatile("s_waitcnt vmcnt(0)" ::: "memory");
        } else {
            XB_SPIN(xb_ld(&bar[XB_XGEN(b.x)]) == gen, bar);
            __builtin_amdgcn_fence(__ATOMIC_ACQUIRE, "agent");
            asm volatile("s_waitcnt vmcnt(0)" ::: "memory");
        }
    }
    __syncthreads();
}

struct Frame {
    LAS unsigned char* lds;
    int tid, lane, wave, G, bid;
    const float *xp, *xs, *ck, *cv, *st, *w_in, *lbl, *hnw, *sinks, *w_ua, *w_ub, *w_o, *n1, *n2, *w_f1, *w_f2, *nf;
    float* out;
    bf16_t *Win_t, *Wua_t, *Wub_t, *Wo_t, *W1_t, *W2_t;
    float *LB, *GD, *SSQ1, *SSQ2, *LF; f32x2* ROT;
    bf16_t *XN, *DS, *MM, *X1B, *QH, *VH, *GH, *SQ, *SK, *SV, *GA, *GB, *HID;
};
__device__ __forceinline__ const float* xrow(const Frame& F, int row) { return row < MP ? F.xp + (size_t)row * DM : F.xs + (size_t)(row - MP) * DM; }
__device__ __forceinline__ int rot_index(int row) { return row < MP ? (row & (SEQ - 1)) : SEQ + (row & 3); }

__device__ __forceinline__ float wave_sum(float v) {
#pragma unroll
    for (int o = 1; o < 64; o <<= 1) v += __shfl_xor(v, o);
    return v;
}

__device__ __forceinline__ void p0_transpose_item(const float* W, int K, int N, bf16_t* WT, const float* ks, LAS float* scr, int item, int lane) {
    const int nblk = N / 32, kb = item / nblk, nb = item % nblk, k0 = 64 * kb, n0 = 32 * nb;
#pragma unroll 8
    for (int i = 0; i < 32; ++i) { const int kk = 2 * i + (lane >> 5); float w = W[(size_t)(k0 + kk) * N + n0 + (lane & 31)]; if (ks) w *= ks[k0 + kk]; scr[kk * 33 + (lane & 31)] = w; }
    asm volatile("s_waitcnt lgkmcnt(0)" ::: "memory");
    const int c = lane & 7;
#pragma unroll
    for (int j = 0; j < 4; ++j) { const int n = (lane >> 3) + 8 * j; const LAS float* s = scr + (8 * c) * 33 + n;
        u32x4 o; o.x = pk2(s[0 * 33], s[1 * 33]); o.y = pk2(s[2 * 33], s[3 * 33]); o.z = pk2(s[4 * 33], s[5 * 33]); o.w = pk2(s[6 * 33], s[7 * 33]);
        *(u32x4*)(WT + (size_t)(n0 + n) * K + k0 + 8 * c) = o; }
    asm volatile("s_waitcnt lgkmcnt(0)" ::: "memory");
}
__device__ __forceinline__ void p0_prologue(Frame& F) {
    LAS float* scr = (LAS float*)(F.lds + F.wave * 16384);
    const int gw = F.bid * NWAVES + F.wave, NGW = F.G * NWAVES;
    constexpr int I_IN = (DM / 64) * (DIN / 32), I_UA = (512 / 64) * (DM / 32), I_O = (DM / 64) * (DM / 32), I_1 = (DM / 64) * (DFF / 32), I_2 = (DFF / 64) * (DM / 32);
    constexpr int NITEMS = I_IN + 2 * I_UA + I_O + I_1 + I_2;
    for (int it = gw; it < NITEMS; it += NGW) {
        int r = it;
        if (r < I_IN) { p0_transpose_item(F.w_in, DM, DIN, F.Win_t, nullptr, scr, r, F.lane); continue; } r -= I_IN;
        if (r < I_UA) { p0_transpose_item(F.w_ua, 512, DM, F.Wua_t, nullptr, scr, r, F.lane); continue; } r -= I_UA;
        if (r < I_UA) { p0_transpose_item(F.w_ub, 512, DM, F.Wub_t, nullptr, scr, r, F.lane); continue; } r -= I_UA;
        if (r < I_O) { p0_transpose_item(F.w_o, DM, DM, F.Wo_t, nullptr, scr, r, F.lane); continue; } r -= I_O;
        if (r < I_1) { p0_transpose_item(F.w_f1, DM, DFF, F.W1_t, F.n2, scr, r, F.lane); continue; } r -= I_1;
        p0_transpose_item(F.w_f2, DFF, DM, F.W2_t, nullptr, scr, r, F.lane);
    }
    for (int m = gw; m < M; m += NGW) {
        const f32x4* xr = (const f32x4*)xrow(F, m) + F.lane; const f32x4* wn = (const f32x4*)F.n1 + F.lane;
        f32x4 v[4]; float s = 0.f;
#pragma unroll
        for (int j = 0; j < 4; ++j) { v[j] = xr[64 * j]; s += (v[j].x * v[j].x + v[j].y * v[j].y) + (v[j].z * v[j].z + v[j].w * v[j].w); }
        const float rstd = 1.0f / sqrtf(wave_sum(s) * (1.f / DM) + EPS);
        u32x2* o8 = (u32x2*)(F.XN + (size_t)m * DM) + F.lane;
#pragma unroll
        for (int j = 0; j < 4; ++j) { const f32x4 w = wn[64 * j]; u32x2 o; o.x = pk2(v[j].x * rstd * w.x, v[j].y * rstd * w.y); o.y = pk2(v[j].z * rstd * w.z, v[j].w * rstd * w.w); o8[64 * j] = o; }
    }
    const int gt = F.bid * (NWAVES * 64) + F.tid, NGT = F.G * NWAVES * 64;
    for (int i = gt; i < 512; i += NGT) { const float a = F.lbl[i], b = F.lbl[512 + i]; F.LB[i] = 1.0f / (1.0f + expf(b - a)); }
    for (int i = gt; i < (SEQ + DT) * 8; i += NGT) {
        const int pi = i >> 3, j = i & 7; const double pos = pi < SEQ ? (double)pi : (double)(PAST + (pi - SEQ));
        const double inv = exp(-13.122363377404328 * (double)j * 0.125);
        const double ang = pos * inv; F.ROT[i] = (f32x2){(float)cos(ang), (float)sin(ang)};
    }
}

using pg8::Unit;
struct EpiIn {
    bf16_t *QH, *VH, *GH, *SQ, *SK, *SV, *GA, *GB; float* LF; const float* LB; const f32x2* ROT;
    __device__ __forceinline__ void operator()(const f32x4 (&acc)[2][2][4][2], const Unit& u, int wr, int wc, int fr, int fq) const {
        const int pn = u.pn;
#pragma unroll
        for (int ai = 0; ai < 2; ++ai)
#pragma unroll
            for (int m = 0; m < 4; ++m) {
                const int row = u.pm * 256 + ai * 128 + wr * 64 + m * 16 + fr;
#pragma unroll
                for (int bj = 0; bj < 2; ++bj) {
                    const int col = pn * 256 + bj * 128 + wc * 32 + 8 * fq;
                    float v[8];
#pragma unroll
                    for (int j = 0; j < 4; ++j) { v[j] = acc[ai][bj][m][0][j]; v[4 + j] = acc[ai][bj][m][1][j]; }
                    bf16_t* dst = nullptr;
                    if (pn < 2) { dst = QH + (size_t)row * 512 + col; }
                    else if (pn < 4) {
                        const int c = col - 512; const f32x4 l0 = *(const f32x4*)(LB + c), l1 = *(const f32x4*)(LB + c + 4);
                        float lbv[8] = {l0.x, l0.y, l0.z, l0.w, l1.x, l1.y, l1.z, l1.w};
#pragma unroll
                        for (int j = 0; j < 8; ++j) v[j] = __logf(lbv[j] + (1.0f - lbv[j]) * sigmoidf_(v[j]));
                        float* d = LF + (size_t)row * 512 + c;
                        *(f32x4*)d = (f32x4){v[0], v[1], v[2], v[3]}; *(f32x4*)(d + 4) = (f32x4){v[4], v[5], v[6], v[7]};
                    }
                    else if (pn < 6) { dst = VH + (size_t)row * 512 + (col - 1024); }
                    else if (pn < 8) {
#pragma unroll
                        for (int j = 0; j < 8; ++j) v[j] = v[j] * sigmoidf_(v[j]);
                        dst = GH + (size_t)row * 512 + (col - 1536);
                    }
                    else if (pn < 11) {
                        const bool isv = (pn == 10 && bj == 1);
                        if (!isv && !(wc & 1)) {
                            const f32x2* rt = ROT + (size_t)rot_index(row) * 8;
                            float o[8];
#pragma unroll
                            for (int j = 0; j < 8; ++j) o[j] = __shfl_xor(v[j], 16);
                            if (fq < 2) {
#pragma unroll
                                for (int j = 0; j < 8; ++j) { const f32x2 cs = rt[j]; v[j] = (fq == 0) ? (v[j] * cs.x - o[j] * cs.y) : (v[j] * cs.x + o[j] * cs.y); }
                            }
                        }
                        if (pn < 10) dst = SQ + (size_t)row * 512 + (col - 2048);
                        else if (bj == 0) dst = SK + (size_t)row * 128 + (col - 2560);
                        else dst = SV + (size_t)row * 128 + (col - 2688);
                    }
                    else {
#pragma unroll
                        for (int j = 0; j < 8; ++j) v[j] = sigmoidf_(v[j]);
                        if (pn < 15) dst = GA + (size_t)row * 1024 + (col - 2816); else dst = GB + (size_t)row * 1024 + (col - 3840);
                    }
                    if (dst) { u32x4 w; w.x = pk2(v[0], v[1]); w.y = pk2(v[2], v[3]); w.z = pk2(v[4], v[5]); w.w = pk2(v[6], v[7]); *(u32x4*)dst = w; }
                }
            }
    }
};
struct EpiUp {
    bf16_t* MM; const bf16_t *GA, *GB;
    __device__ __forceinline__ float m4(int row, int col, const f32x4& a, const f32x4& b) const {
        const size_t off = (size_t)row * 1024 + col; const u32x2 ga = *(const u32x2*)(GA + off), gb = *(const u32x2*)(GB + off);
        u32x2 o; o.x = pk2(a.x * bflo(ga.x) + b.x * bflo(gb.x), a.y * bfhi(ga.x) + b.y * bfhi(gb.x)); o.y = pk2(a.z * bflo(ga.y) + b.z * bflo(gb.y), a.w * bfhi(ga.y) + b.w * bfhi(gb.y));
        *(u32x2*)(MM + off) = o; return 0.f;
    }
    __device__ __forceinline__ void mss(int, int, float) const {}
    __device__ __forceinline__ void operator()(const f32x4 (&acc)[2][2][4][2], const Unit& u, int wr, int wc, int fr, int fq) const {
#pragma unroll
        for (int ai = 0; ai < 2; ++ai)
#pragma unroll
            for (int m = 0; m < 4; ++m) {
                const int row = u.pm * 256 + ai * 128 + wr * 64 + m * 16 + fr;
#pragma unroll
                for (int bj = 0; bj < 2; ++bj) {
                    const size_t off = (size_t)row * 1024 + u.pn * 256 + bj * 128 + wc * 32 + 8 * fq;
                    const u32x4 gt = *(const u32x4*)((u.z ? GB : GA) + off);
                    float v[8];
                    v[0] = acc[ai][bj][m][0][0] * bflo(gt.x); v[1] = acc[ai][bj][m][0][1] * bfhi(gt.x); v[2] = acc[ai][bj][m][0][2] * bflo(gt.y); v[3] = acc[ai][bj][m][0][3] * bfhi(gt.y);
                    v[4] = acc[ai][bj][m][1][0] * bflo(gt.z); v[5] = acc[ai][bj][m][1][1] * bfhi(gt.z); v[6] = acc[ai][bj][m][1][2] * bflo(gt.w); v[7] = acc[ai][bj][m][1][3] * bfhi(gt.w);
                    if (u.z) { const u32x4 p = *(const u32x4*)(MM + off);
                        v[0] += bflo(p.x); v[1] += bfhi(p.x); v[2] += bflo(p.y); v[3] += bfhi(p.y); v[4] += bflo(p.z); v[5] += bfhi(p.z); v[6] += bflo(p.w); v[7] += bfhi(p.w); }
                    u32x4 w; w.x = pk2(v[0], v[1]); w.y = pk2(v[2], v[3]); w.z = pk2(v[4], v[5]); w.w = pk2(v[6], v[7]); *(u32x4*)(MM + off) = w;
                }
            }
    }
};
struct EpiWo {
    const float *xp, *xs; float* out; bf16_t* X1B; float* SSQ;
    __device__ __forceinline__ float m4(int row, int col, const f32x4& acc, const f32x4&) const {
        const float* xr = row < MP ? xp + (size_t)row * DM : xs + (size_t)(row - MP) * DM;
        const f32x4 a = *(const f32x4*)(xr + col) + acc;
        *(f32x4*)(out + (size_t)row * DM + col) = a;
        u32x2 w; w.x = pk2(a.x, a.y); w.y = pk2(a.z, a.w); *(u32x2*)(X1B + (size_t)row * DM + col) = w;
        return (a.x * a.x + a.y * a.y) + (a.z * a.z + a.w * a.w);
    }
    __device__ __forceinline__ void mss(int row, int slot, float ss) const { SSQ[(size_t)row * 16 + slot] = ss; }
    __device__ __forceinline__ void operator()(const f32x4 (&acc)[2][2][4][2], const Unit& u, int wr, int wc, int fr, int fq) const {
#pragma unroll
        for (int ai = 0; ai < 2; ++ai)
#pragma unroll
            for (int m = 0; m < 4; ++m) {
                const int row = u.pm * 256 + ai * 128 + wr * 64 + m * 16 + fr;
                const float* xr = row < MP ? xp + (size_t)row * DM : xs + (size_t)(row - MP) * DM;
                float ss = 0.f;
#pragma unroll
                for (int bj = 0; bj < 2; ++bj) {
                    const int col = u.pn * 256 + bj * 128 + wc * 32 + 8 * fq;
                    const f32x4 a = *(const f32x4*)(xr + col) + acc[ai][bj][m][0], b = *(const f32x4*)(xr + col + 4) + acc[ai][bj][m][1];
                    ss += (a.x * a.x + a.y * a.y) + (a.z * a.z + a.w * a.w) + (b.x * b.x + b.y * b.y) + (b.z * b.z + b.w * b.w);
                    float* o = out + (size_t)row * DM + col; *(f32x4*)o = a; *(f32x4*)(o + 4) = b;
                    u32x4 w; w.x = pk2(a.x, a.y); w.y = pk2(a.z, a.w); w.z = pk2(b.x, b.y); w.w = pk2(b.z, b.w); *(u32x4*)(X1B + (size_t)row * DM + col) = w;
                }
                ss += __shfl_xor(ss, 16); ss += __shfl_xor(ss, 32);
                if (fq == 0) SSQ[(size_t)row * 16 + u.pn * 4 + wc] = ss;
            }
    }
};
__device__ __forceinline__ float row_rstd(const float* SSQ, int row) {
    const f32x4* p = (const f32x4*)(SSQ + (size_t)row * 16); const f32x4 a = p[0], b = p[1], c = p[2], d = p[3];
    const float s = ((a.x + a.y) + (a.z + a.w)) + ((b.x + b.y) + (b.z + b.w)) + ((c.x + c.y) + (c.z + c.w)) + ((d.x + d.y) + (d.z + d.w));
    return 1.0f / sqrtf(s * (1.f / DM) + EPS);
}
struct EpiFf1 {
    bf16_t* HID; const float* SSQ;
    __device__ __forceinline__ float m4(int row, int col, const f32x4& acc, const f32x4&) const {
        const float rs = row_rstd(SSQ, row);
        const float t0 = fmaxf(acc.x * rs, 0.f), t1 = fmaxf(acc.y * rs, 0.f), t2 = fmaxf(acc.z * rs, 0.f), t3 = fmaxf(acc.w * rs, 0.f);
        u32x2 w; w.x = pk2(t0 * t0, t1 * t1); w.y = pk2(t2 * t2, t3 * t3); *(u32x2*)(HID + (size_t)row * DFF + col) = w; return 0.f;
    }
    __device__ __forceinline__ void mss(int, int, float) const {}
    __device__ __forceinline__ void operator()(const f32x4 (&acc)[2][2][4][2], const Unit& u, int wr, int wc, int fr, int fq) const {
#pragma unroll
        for (int ai = 0; ai < 2; ++ai)
#pragma unroll
            for (int m = 0; m < 4; ++m) {
                const int row = u.pm * 256 + ai * 128 + wr * 64 + m * 16 + fr;
                const float rs = row_rstd(SSQ, row);
#pragma unroll
                for (int bj = 0; bj < 2; ++bj) {
                    float v[8];
#pragma unroll
                    for (int j = 0; j < 4; ++j) { v[j] = acc[ai][bj][m][0][j]; v[4 + j] = acc[ai][bj][m][1][j]; }
#pragma unroll
                    for (int j = 0; j < 8; ++j) { const float t = fmaxf(v[j] * rs, 0.f); v[j] = t * t; }
                    u32x4 w; w.x = pk2(v[0], v[1]); w.y = pk2(v[2], v[3]); w.z = pk2(v[4], v[5]); w.w = pk2(v[6], v[7]);
                    *(u32x4*)(HID + (size_t)row * DFF + u.pn * 256 + bj * 128 + wc * 32 + 8 * fq) = w;
                }
            }
    }
};
struct EpiFf2 {
    float* out; float* SSQ;
    __device__ __forceinline__ float m4(int row, int col, const f32x4& acc, const f32x4&) const {
        float* o = out + (size_t)row * DM + col; const f32x4 a = *(const f32x4*)o + acc; *(f32x4*)o = a;
        return (a.x * a.x + a.y * a.y) + (a.z * a.z + a.w * a.w);
    }
    __device__ __forceinline__ void mss(int row, int slot, float ss) const { SSQ[(size_t)row * 16 + slot] = ss; }
    __device__ __forceinline__ void operator()(const f32x4 (&acc)[2][2][4][2], const Unit& u, int wr, int wc, int fr, int fq) const {
#pragma unroll
        for (int ai = 0; ai < 2; ++ai)
#pragma unroll
            for (int m = 0; m < 4; ++m) {
                const int row = u.pm * 256 + ai * 128 + wr * 64 + m * 16 + fr;
                float ss = 0.f;
#pragma unroll
                for (int bj = 0; bj < 2; ++bj) {
                    float* o = out + (size_t)row * DM + u.pn * 256 + bj * 128 + wc * 32 + 8 * fq;
                    const f32x4 a = *(const f32x4*)o + acc[ai][bj][m][0], b = *(const f32x4*)(o + 4) + acc[ai][bj][m][1];
                    ss += (a.x * a.x + a.y * a.y) + (a.z * a.z + a.w * a.w) + (b.x * b.x + b.y * b.y) + (b.z * b.z + b.w * b.w);
                    *(f32x4*)o = a; *(f32x4*)(o + 4) = b;
                }
                ss += __shfl_xor(ss, 16); ss += __shfl_xor(ss, 32);
                if (fq == 0) SSQ[(size_t)row * 16 + u.pn * 4 + wc] = ss;
            }
    }
};

struct MiniBuf { bf16x8 a[2][4], b[2][4]; };
template <int NT, int NPASS, class Epi>
__device__ __forceinline__ void mini_gemm(Frame& F, const bf16_t* A0, const bf16_t* B0, const bf16_t* A1, const bf16_t* B1, const int K, const Epi& E) {
    constexpr int NCS = NT / 32, KS = 8 / NCS, LDR = NT + 4;
    const int tid = F.tid, lane = F.lane, w = F.wave, fr = lane & 15, fq = lane >> 4;
    const int cs = w % NCS, kq = w / NCS;
    const int klen = K / KS, kbeg = kq * klen, nb = klen / 128;
    LAS float* RED = (LAS float*)F.lds;
    for (int tile = F.bid; tile < 256; tile += F.G) {
        const int xcd = tile & 7, idx = tile >> 3, ct = xcd * 2 + (idx & 1), mt = idx >> 1;
        const int row0 = MP + 32 * mt, col0 = NT * ct + 32 * cs;
        f32x4 acc[NPASS][2][2];
#pragma unroll
        for (int p = 0; p < NPASS; ++p)
#pragma unroll
            for (int i = 0; i < 2; ++i)
#pragma unroll
                for (int j = 0; j < 2; ++j) acc[p][i][j] = (f32x4){0.f, 0.f, 0.f, 0.f};
#pragma unroll
        for (int p = 0; p < NPASS; ++p) {
            const bf16_t* Ap = (p ? A1 : A0) + (size_t)(row0 + fr) * K + kbeg + 8 * fq;
            const bf16_t* Bp = (p ? B1 : B0) + (size_t)(col0 + fr) * K + kbeg + 8 * fq;
#define MG_LOAD(buf, kk) do { _Pragma("unroll") for (int s_ = 0; s_ < 4; ++s_) _Pragma("unroll") for (int i_ = 0; i_ < 2; ++i_) { \
                buf.a[i_][s_] = *(const bf16x8*)(Ap + (size_t)(16 * i_) * K + (kk) + 32 * s_); buf.b[i_][s_] = *(const bf16x8*)(Bp + (size_t)(16 * i_) * K + (kk) + 32 * s_); } } while (0)
#define MG_COMP(buf) do { _Pragma("unroll") for (int s_ = 0; s_ < 4; ++s_) _Pragma("unroll") for (int i_ = 0; i_ < 2; ++i_) _Pragma("unroll") for (int j_ = 0; j_ < 2; ++j_) \
                acc[p][i_][j_] = MFMA16(buf.b[j_][s_], buf.a[i_][s_], acc[p][i_][j_]); } while (0)
            MiniBuf b0, b1;
            MG_LOAD(b0, 0);
            if (nb == 1) { MG_COMP(b0); }
            else {
                for (int i = 0; i < nb; i += 2) {
                    MG_LOAD(b1, (i + 1) * 128);
                    MG_COMP(b0);
                    const int k2 = (i + 2 < nb) ? (i + 2) * 128 : 0;
                    MG_LOAD(b0, k2);
                    MG_COMP(b1);
                }
            }
#undef MG_LOAD
#undef MG_COMP
        }
        if (KS == 1) {
#pragma unroll
            for (int i = 0; i < 2; ++i)
#pragma unroll
                for (int j = 0; j < 2; ++j) (void)E.m4(row0 + 16 * i + fr, col0 + 16 * j + 4 * fq, acc[0][i][j], acc[NPASS - 1][i][j]);
        } else {
#pragma unroll
            for (int p = 0; p < NPASS; ++p)
#pragma unroll
                for (int i = 0; i < 2; ++i)
#pragma unroll
                    for (int j = 0; j < 2; ++j) *(LAS f32x4*)(RED + ((kq * NPASS + p) * 32 + 16 * i + fr) * LDR + 32 * cs + 16 * j + 4 * fq) = acc[p][i][j];
            __syncthreads();
            const int row = tid >> 4, c4 = (tid & 15) * 4;
            f32x4 v[NPASS];
#pragma unroll
            for (int p = 0; p < NPASS; ++p) { v[p] = (f32x4){0.f, 0.f, 0.f, 0.f};
#pragma unroll
                for (int q = 0; q < KS; ++q) v[p] += *(const LAS f32x4*)(RED + ((q * NPASS + p) * 32 + row) * LDR + c4); }
            float ss = E.m4(row0 + row, NT * ct + c4, v[0], v[NPASS - 1]);
            ss += __shfl_xor(ss, 1); ss += __shfl_xor(ss, 2); ss += __shfl_xor(ss, 4); ss += __shfl_xor(ss, 8);
            if ((tid & 15) == 0) E.mss(row0 + row, ct, ss);
            __syncthreads();
        }
    }
}

__device__ __forceinline__ void chunk_cumsum(const float* LFp  , LAS float* PART, int tq, int d, float (&lfv)[16], float (&cs)[16], float& pre, float& tot, float& mid) {
    const float* p = LFp + (size_t)(16 * tq) * 512 + d;
#pragma unroll
    for (int i = 0; i < 16; ++i) lfv[i] = p[(size_t)i * 512];
    float run = 0.f;
#pragma unroll
    for (int i = 0; i < 16; ++i) { run += lfv[i]; cs[i] = run; }
    PART[tq * 128 + d] = run;
    __syncthreads();
    const float p0 = PART[d], p1 = PART[128 + d], p2 = PART[256 + d], p3 = PART[384 + d];
    mid = p0 + p1; tot = (p0 + p1) + (p2 + p3);
    pre = tq == 0 ? 0.f : (tq == 1 ? p0 : (tq == 2 ? p0 + p1 : (p0 + p1) + p2));
}
__device__ __forceinline__ void fill_vt(const bf16_t* VHp  , LAS bf16_t* VT, int tid) {
    const int t = tid & 63, ech = tid >> 6;
    const u32x4* src = (const u32x4*)(VHp + (size_t)t * 512 + 16 * ech);
    const u32x4 a = src[0], b = src[1];
    const unsigned w[8] = {a.x, a.y, a.z, a.w, b.x, b.y, b.z, b.w};
#pragma unroll
    for (int j = 0; j < 8; ++j) { VT[(16 * ech + 2 * j) * 72 + t] = (bf16_t)(w[j] & 0xffffu); VT[(16 * ech + 2 * j + 1) * 72 + t] = (bf16_t)(w[j] >> 16); }
}

__device__ __forceinline__ void hgrn_pass1(Frame& F, int item) {
    const int tid = F.tid, lane = F.lane, w = F.wave, fr = lane & 15, fq = lane >> 4;
    const int bh = item >> 6, c = item & 63, b = bh >> 2, h = bh & 3, R0 = b * SEQ + c * 64;
    LAS float* PART = (LAS float*)F.lds; LAS bf16_t* KT = (LAS bf16_t*)(F.lds + 2048); LAS bf16_t* VT = (LAS bf16_t*)(F.lds + 2048 + 18432);
    const int tq = tid >> 7, d = tid & 127;
    float lfv[16], cs[16], pre, tot, mid;
    chunk_cumsum(F.LF + (size_t)R0 * 512 + h * 128, PART, tq, d, lfv, cs, pre, tot, mid);
    {
        unsigned pk[8];
#pragma unroll
        for (int i = 0; i < 8; ++i) {
            const float k0 = (1.0f - __expf(lfv[2 * i])) * __expf(tot - (pre + cs[2 * i])), k1 = (1.0f - __expf(lfv[2 * i + 1])) * __expf(tot - (pre + cs[2 * i + 1]));
            pk[i] = pk2(k0, k1);
        }
        LAS u32x4* dst = (LAS u32x4*)(KT + d * 72 + 16 * tq);
        dst[0] = (u32x4){pk[0], pk[1], pk[2], pk[3]}; dst[1] = (u32x4){pk[4], pk[5], pk[6], pk[7]};
        if (tq == 0) F.GD[(size_t)item * 128 + d] = __expf(tot);
    }
    fill_vt(F.VH + (size_t)R0 * 512 + h * 128, VT, tid);
    __syncthreads();
    bf16x8 a[2];
#pragma unroll
    for (int ks = 0; ks < 2; ++ks) a[ks] = *(const LAS bf16x8*)(KT + (16 * w + fr) * 72 + 32 * ks + 8 * fq);
    bf16_t* dsb = F.DS + (size_t)item * 16384;
#pragma unroll
    for (int et = 0; et < 8; ++et) {
        f32x4 acc = {0.f, 0.f, 0.f, 0.f};
#pragma unroll
        for (int ks = 0; ks < 2; ++ks) { const bf16x8 bb = *(const LAS bf16x8*)(VT + (16 * et + fr) * 72 + 32 * ks + 8 * fq); acc = MFMA16(a[ks], bb, acc); }
        u32x2 o; o.x = pk2(acc[0], acc[1]); o.y = pk2(acc[2], acc[3]);
        *(u32x2*)(dsb + (16 * et + fr) * 128 + 16 * w + 4 * fq) = o;
    }
    __syncthreads();
}

__device__ __forceinline__ void hgrn_pass2(Frame& F) {
    if (F.tid >= 128) return;
    const int gt = F.bid * 128 + F.tid;
    if (gt >= 16 * 128 * 16) return;
    const int bh = gt >> 11, rem = gt & 2047, e = rem >> 4, d8 = (rem & 15) * 8;
    float S[8];
#pragma unroll
    for (int i = 0; i < 8; ++i) S[i] = 0.f;
    for (int c = 0; c < 64; c += 4) {
        u32x4 dv[4]; f32x4 g0[4], g1[4];
#pragma unroll
        for (int k = 0; k < 4; ++k) {
            const size_t it = (size_t)bh * 64 + c + k;
            dv[k] = *(const u32x4*)(F.DS + it * 16384 + e * 128 + d8);
            g0[k] = *(const f32x4*)(F.GD + it * 128 + d8); g1[k] = *(const f32x4*)(F.GD + it * 128 + d8 + 4);
        }
#pragma unroll
        for (int k = 0; k < 4; ++k) {
            const size_t it = (size_t)bh * 64 + c + k;
            u32x4 o; o.x = pk2(S[0], S[1]); o.y = pk2(S[2], S[3]); o.z = pk2(S[4], S[5]); o.w = pk2(S[6], S[7]);
            *(u32x4*)(F.DS + it * 16384 + e * 128 + d8) = o;
            S[0] = g0[k].x * S[0] + bflo(dv[k].x); S[1] = g0[k].y * S[1] + bfhi(dv[k].x); S[2] = g0[k].z * S[2] + bflo(dv[k].y); S[3] = g0[k].w * S[3] + bfhi(dv[k].y);
            S[4] = g1[k].x * S[4] + bflo(dv[k].z); S[5] = g1[k].y * S[5] + bfhi(dv[k].z); S[6] = g1[k].z * S[6] + bflo(dv[k].w); S[7] = g1[k].w * S[7] + bfhi(dv[k].w);
        }
    }
    float* o = F.out + O_NSP + (size_t)bh * 16384 + (size_t)d8 * 128 + e;
#pragma unroll
    for (int i = 0; i < 8; ++i) o[(size_t)i * 128] = S[i];
}

__device__ __forceinline__ void hgrn_pass3(Frame& F, int item) {
    const int tid = F.tid, lane = F.lane, w = F.wave, fr = lane & 15, fq = lane >> 4;
    const int bh = item >> 6, c = item & 63, b = bh >> 2, h = bh & 3, R0 = b * SEQ + c * 64;
    LAS float* PART = (LAS float*)F.lds;
    LAS bf16_t* QI = (LAS bf16_t*)(F.lds + 2048); LAS bf16_t* QA = (LAS bf16_t*)(F.lds + 19456); LAS bf16_t* KA = (LAS bf16_t*)(F.lds + 36864);
    LAS bf16_t* VT = (LAS bf16_t*)(F.lds + 54272); LAS bf16_t* AT = (LAS bf16_t*)(F.lds + 72704); LAS float* RED = (LAS float*)(F.lds + 81920);
    const int tq = tid >> 7, d = tid & 127;
    float lfv[16], cs[16], pre, tot, mid;
    float qv[16];
    { const bf16_t* qp = F.QH + (size_t)(R0 + 16 * tq) * 512 + h * 128 + d;
#pragma unroll
      for (int i = 0; i < 16; ++i) qv[i] = bf2f(qp[(size_t)i * 512]); }
    chunk_cumsum(F.LF + (size_t)R0 * 512 + h * 128, PART, tq, d, lfv, cs, pre, tot, mid);
#pragma unroll
    for (int i = 0; i < 16; ++i) {
        const int t = 16 * tq + i; const float bb = pre + cs[i];
        const float qi = qv[i] * __expf(bb), qa = qv[i] * __expf(bb - mid), ka = (1.0f - __expf(lfv[i])) * __expf(mid - bb);
        QI[t * 136 + d] = (bf16_t)(pk2(qi, 0.f) & 0xffffu); QA[t * 136 + d] = (bf16_t)(pk2(qa, 0.f) & 0xffffu); KA[t * 136 + d] = (bf16_t)(pk2(ka, 0.f) & 0xffffu);
    }
    fill_vt(F.VH + (size_t)R0 * 512 + h * 128, VT, tid);
    __syncthreads();
    {
        const int tt = w & 3;
#pragma unroll
        for (int si = 0; si < 2; ++si) {
            const int st = 2 * (w >> 2) + si;
            f32x4 acc = {0.f, 0.f, 0.f, 0.f};
            if (st <= tt) {
#pragma unroll
                for (int ks = 0; ks < 4; ++ks) {
                    const bf16x8 aa = *(const LAS bf16x8*)(KA + (16 * st + fr) * 136 + 32 * ks + 8 * fq);
                    const bf16x8 bb = *(const LAS bf16x8*)(QA + (16 * tt + fr) * 136 + 32 * ks + 8 * fq);
                    acc = MFMA16(aa, bb, acc);
                }
            }
            const int t = 16 * tt + fr, s0 = 16 * st + 4 * fq;
            float p[4];
#pragma unroll
            for (int r = 0; r < 4; ++r) p[r] = (s0 + r <= t) ? acc[r] : 0.f;
            u32x2 o; o.x = pk2(p[0], p[1]); o.y = pk2(p[2], p[3]);
            *(LAS u32x2*)(AT + t * 72 + s0) = o;
        }
    }
    __syncthreads();
    f32x4 oacc[4];
#pragma unroll
    for (int tt = 0; tt < 4; ++tt) oacc[tt] = (f32x4){0.f, 0.f, 0.f, 0.f};
    {
        const bf16_t* sp = F.DS + (size_t)item * 16384 + (size_t)(16 * w + fr) * 128 + 8 * fq;
#pragma unroll
        for (int ks = 0; ks < 4; ++ks) {
            const bf16x8 aa = *(const bf16x8*)(sp + 32 * ks);
#pragma unroll
            for (int tt = 0; tt < 4; ++tt) { const bf16x8 bb = *(const LAS bf16x8*)(QI + (16 * tt + fr) * 136 + 32 * ks + 8 * fq); oacc[tt] = MFMA16(aa, bb, oacc[tt]); }
        }
#pragma unroll
        for (int ks = 0; ks < 2; ++ks) {
            const bf16x8 aa = *(const LAS bf16x8*)(VT + (16 * w + fr) * 72 + 32 * ks + 8 * fq);
#pragma unroll
            for (int tt = 0; tt < 4; ++tt) { const bf16x8 bb = *(const LAS bf16x8*)(AT + (16 * tt + fr) * 72 + 32 * ks + 8 * fq); oacc[tt] = MFMA16(aa, bb, oacc[tt]); }
        }
    }
#pragma unroll
    for (int tt = 0; tt < 4; ++tt) {
        float p = (oacc[tt][0] * oacc[tt][0] + oacc[tt][1] * oacc[tt][1]) + (oacc[tt][2] * oacc[tt][2] + oacc[tt][3] * oacc[tt][3]);
        p += __shfl_xor(p, 16); p += __shfl_xor(p, 32);
        if (fq == 0) RED[w * 64 + 16 * tt + fr] = p;
    }
    __syncthreads();
    {
        const int e0 = 16 * w + 4 * fq;
        const f32x4 hw = *(const f32x4*)(F.hnw + h * 128 + e0);
#pragma unroll
        for (int tt = 0; tt < 4; ++tt) {
            const int t = 16 * tt + fr;
            float s = 0.f;
#pragma unroll
            for (int ww = 0; ww < 8; ++ww) s += RED[ww * 64 + t];
            const float rs = 1.0f / sqrtf(s * (1.f / 128.f) + EPS);
            const size_t off = (size_t)(R0 + t) * 512 + h * 128 + e0;
            const u32x2 gg = *(const u32x2*)(F.GH + off);
            u32x2 o; o.x = pk2(oacc[tt][0] * rs * hw.x * bflo(gg.x), oacc[tt][1] * rs * hw.y * bfhi(gg.x)); o.y = pk2(oacc[tt][2] * rs * hw.z * bflo(gg.y), oacc[tt][3] * rs * hw.w * bfhi(gg.y));
            *(u32x2*)(F.QH + off) = o;
        }
    }
    __syncthreads();
}

__device__ __forceinline__ void swa_prompt(Frame& F, int item) {
    const int tid = F.tid, lane = F.lane, w = F.wave, fr = lane & 15, fq = lane >> 4;
    const int kvh = item & 1, nb = (item >> 1) & 31, b = item >> 6;
    LAS bf16_t* KS = (LAS bf16_t*)F.lds;
    LAS bf16_t* VT = (LAS bf16_t*)(F.lds + 36864);
    const int tok0 = nb * 128 - 128;
    {
        const int j = tid >> 1, half = tid & 1; const int tok = tok0 + j;
        u32x4 v0 = {0u, 0u, 0u, 0u}, v1 = v0, v2 = v0, v3 = v0;
        if (tok >= 0) { const u32x4* src = (const u32x4*)(F.SK + (size_t)(b * SEQ + tok) * 128 + kvh * 64 + 32 * half); v0 = src[0]; v1 = src[1]; v2 = src[2]; v3 = src[3]; }
        LAS u32x4* dst = (LAS u32x4*)(KS + j * 72 + 32 * half); dst[0] = v0; dst[1] = v1; dst[2] = v2; dst[3] = v3;
    }
    {
        const int j = tid & 255, half = tid >> 8; const int tok = tok0 + j;
        u32x4 v[4]; v[0] = (u32x4){0u, 0u, 0u, 0u}; v[1] = v[0]; v[2] = v[0]; v[3] = v[0];
        if (tok >= 0) { const u32x4* src = (const u32x4*)(F.SV + (size_t)(b * SEQ + tok) * 128 + kvh * 64 + 32 * half); v[0] = src[0]; v[1] = src[1]; v[2] = src[2]; v[3] = src[3]; }
#pragma unroll
        for (int q = 0; q < 4; ++q) {
            const unsigned ww[4] = {v[q].x, v[q].y, v[q].z, v[q].w};
#pragma unroll
            for (int k = 0; k < 4; ++k) { const int dd = 32 * half + 8 * q + 2 * k; VT[dd * 264 + j] = (bf16_t)(ww[k] & 0xffffu); VT[(dd + 1) * 264 + j] = (bf16_t)(ww[k] >> 16); }
        }
    }
    __syncthreads();
    if (nb == 31) {
        for (int i = tid; i < 128 * 64; i += 512) { const int jj = i >> 6, dd = i & 63; const size_t o = ((size_t)(b * 128 + jj) * 2 + kvh) * 64 + dd;
            F.out[O_NKP + o] = bf2f(KS[(128 + jj) * 72 + dd]); F.out[O_NVP + o] = bf2f(VT[dd * 264 + 128 + jj]); }
    }
    const int rowq = b * SEQ + nb * 128 + 16 * w + fr;
#pragma unroll 1
    for (int g = 0; g < 4; ++g) {
        const int head = 4 * kvh + g;
        bf16x8 qf[2];
#pragma unroll
        for (int ks = 0; ks < 2; ++ks) qf[ks] = *(const bf16x8*)(F.SQ + (size_t)rowq * 512 + head * 64 + 32 * ks + 8 * fq);
        f32x4 sc[9];
#pragma unroll
        for (int kt = 0; kt < 9; ++kt) {
            f32x4 acc = {0.f, 0.f, 0.f, 0.f};
#pragma unroll
            for (int ks = 0; ks < 2; ++ks) { const bf16x8 aa = *(const LAS bf16x8*)(KS + (16 * w + 16 * kt + fr) * 72 + 32 * ks + 8 * fq); acc = MFMA16(aa, qf[ks], acc); }
            sc[kt] = acc;
        }
        float mx = -1e30f;
#pragma unroll
        for (int kt = 0; kt < 9; ++kt)
#pragma unroll
            for (int r = 0; r < 4; ++r) {
                const int dj = 16 * kt + 4 * fq + r - fr, j = 16 * w + 16 * kt + 4 * fq + r;
                const bool ok = (dj >= 1) && (dj <= 128) && (nb > 0 || j >= 128);
                const float s = ok ? sc[kt][r] * 0.125f : -1e30f;
                sc[kt][r] = s; mx = fmaxf(mx, s);
            }
        mx = fmaxf(mx, __shfl_xor(mx, 16)); mx = fmaxf(mx, __shfl_xor(mx, 32));
        const float sink = F.sinks[head];
        mx = fmaxf(mx, sink);
        float sum = 0.f;
#pragma unroll
        for (int kt = 0; kt < 9; ++kt)
#pragma unroll
            for (int r = 0; r < 4; ++r) { const float p = __expf(sc[kt][r] - mx); sc[kt][r] = p; sum += p; }
        sum += __shfl_xor(sum, 16); sum += __shfl_xor(sum, 32);
        const float inv = 1.0f / (sum + __expf(sink - mx));
        bf16x8 pf[5];
#pragma unroll
        for (int p = 0; p < 5; ++p) {
            u32x4 wv;
            wv.x = pk2(sc[2 * p][0] * inv, sc[2 * p][1] * inv); wv.y = pk2(sc[2 * p][2] * inv, sc[2 * p][3] * inv);
            if (p < 4) { wv.z = pk2(sc[2 * p + 1][0] * inv, sc[2 * p + 1][1] * inv); wv.w = pk2(sc[2 * p + 1][2] * inv, sc[2 * p + 1][3] * inv); } else { wv.z = 0u; wv.w = 0u; }
            pf[p] = __builtin_bit_cast(bf16x8, wv);
        }
#pragma unroll
        for (int dt = 0; dt < 4; ++dt) {
            f32x4 acc = {0.f, 0.f, 0.f, 0.f};
#pragma unroll
            for (int p = 0; p < 5; ++p) {
                const LAS bf16_t* vp = VT + (16 * dt + fr) * 264 + 16 * w + 32 * p + 4 * fq;
                u32x4 av; const u32x2 lo = *(const LAS u32x2*)vp; av.x = lo.x; av.y = lo.y;
                if (p < 4) { const u32x2 hi = *(const LAS u32x2*)(vp + 16); av.z = hi.x; av.w = hi.y; } else { av.z = 0u; av.w = 0u; }
                acc = MFMA16(__builtin_bit_cast(bf16x8, av), pf[p], acc);
            }
            u32x2 o; o.x = pk2(acc[0], acc[1]); o.y = pk2(acc[2], acc[3]);
            *(u32x2*)(F.SQ + (size_t)rowq * 512 + head * 64 + 16 * dt + 4 * fq) = o;
        }
    }
    __syncthreads();
}

__device__ __forceinline__ void hgrn_sample(Frame& F, int item) {
    const int tid = F.tid, bs = item >> 2, h = item & 3;
    LAS float* RED = (LAS float*)F.lds;
    LAS float* RED2 = (LAS float*)(F.lds + 32768);
    const int e4 = tid & 31, dg = tid >> 5;
    const float* sp = F.st + ((size_t)item * 128 + 8 * dg) * 128 + 4 * e4;
    f32x4 S[8];
#pragma unroll
    for (int i = 0; i < 8; ++i) S[i] = *(const f32x4*)(sp + (size_t)i * 128);
#pragma unroll
    for (int t = 0; t < 4; ++t) {
        const size_t rb = (size_t)(MP + bs * 4 + t) * 512 + h * 128;
        const u32x2 vv = *(const u32x2*)(F.VH + rb + 4 * e4);
        const f32x4 v = {bflo(vv.x), bfhi(vv.x), bflo(vv.y), bfhi(vv.y)};
        const f32x4 l0 = *(const f32x4*)(F.LF + rb + 8 * dg), l1 = *(const f32x4*)(F.LF + rb + 8 * dg + 4);
        const u32x4 qq = *(const u32x4*)(F.QH + rb + 8 * dg);
        const float lf[8] = {l0.x, l0.y, l0.z, l0.w, l1.x, l1.y, l1.z, l1.w};
        const float q[8] = {bflo(qq.x), bfhi(qq.x), bflo(qq.y), bfhi(qq.y), bflo(qq.z), bfhi(qq.z), bflo(qq.w), bfhi(qq.w)};
        f32x4 po = {0.f, 0.f, 0.f, 0.f};
#pragma unroll
        for (int i = 0; i < 8; ++i) { const float f = __expf(lf[i]), k = 1.0f - f; S[i] = S[i] * f + v * k; po += S[i] * q[i]; }
        *(LAS f32x4*)(RED + (t * 16 + dg) * 128 + 4 * e4) = po;
    }
    float* op = F.out + O_NSS + ((size_t)item * 128 + 8 * dg) * 128 + 4 * e4;
#pragma unroll
    for (int i = 0; i < 8; ++i) *(f32x4*)(op + (size_t)i * 128) = S[i];
    __syncthreads();
    const int t = tid >> 7, e = tid & 127;
    float o = 0.f;
#pragma unroll
    for (int g = 0; g < 16; ++g) o += RED[(t * 16 + g) * 128 + e];
    const float ss = wave_sum(o * o);
    if (F.lane == 0) RED2[t * 2 + (F.wave & 1)] = ss;
    __syncthreads();
    const float rs = 1.0f / sqrtf((RED2[t * 2] + RED2[t * 2 + 1]) * (1.f / 128.f) + EPS);
    const size_t off = (size_t)(MP + bs * 4 + t) * 512 + h * 128 + e;
    F.QH[off] = (bf16_t)(pk2(o * rs * F.hnw[h * 128 + e] * bf2f(F.GH[off]), 0.f) & 0xffffu);
    __syncthreads();
}

__device__ __forceinline__ void swa_sample(Frame& F, int item) {
    const int tid = F.tid, lane = F.lane, w = F.wave, bs = item >> 1, kvh = item & 1;
    LAS float* Kf = (LAS float*)F.lds;
    LAS float* Vf = (LAS float*)(F.lds + 34560);
    LAS float* Qf = (LAS float*)(F.lds + 68352);
    LAS float* P = (LAS float*)(F.lds + 72512);
    for (int i = tid; i < 132 * 64; i += 512) {
        const int j = i >> 6, dd = i & 63; float kv, vv;
        if (j < 128) { const size_t o = ((size_t)(bs * 128 + j) * 2 + kvh) * 64 + dd; kv = F.ck[o]; vv = F.cv[o]; }
        else { const size_t o = (size_t)(MP + bs * 4 + (j - 128)) * 128 + kvh * 64 + dd; kv = bf2f(F.SK[o]); vv = bf2f(F.SV[o]); }
        Kf[j * 65 + dd] = kv; Vf[j * 64 + dd] = vv;
        if (j >= 4) { const size_t o = ((size_t)(bs * 128 + (j - 4)) * 2 + kvh) * 64 + dd; F.out[O_NKS + o] = kv; F.out[O_NVS + o] = vv; }
    }
    for (int i = tid; i < 16 * 64; i += 512) { const int qr = i >> 6, dd = i & 63, t = qr >> 2, g = qr & 3;
        Qf[qr * 65 + dd] = bf2f(F.SQ[(size_t)(MP + bs * 4 + t) * 512 + (4 * kvh + g) * 64 + dd]); }
    __syncthreads();
    {
        const int qr = tid & 15, jj = tid >> 4, t = qr >> 2;
#pragma unroll 1
        for (int m = 0; m < 5; ++m) {
            const int j = jj + 32 * m;
            if (j < 132) {
                float s = 0.f;
#pragma unroll 16
                for (int dd = 0; dd < 64; ++dd) s += Qf[qr * 65 + dd] * Kf[j * 65 + dd];
                const bool ok = (j >= t + 1) && (j <= t + 128);
                P[qr * 136 + j] = ok ? s * 0.125f : -1e30f;
            }
        }
    }
    __syncthreads();
    {
        const int qr = 2 * w + (lane >> 5), l32 = lane & 31;
        float sv[5]; float mx = -1e30f;
#pragma unroll
        for (int m = 0; m < 5; ++m) { const int j = l32 + 32 * m; sv[m] = (j < 132) ? P[qr * 136 + j] : -1e30f; mx = fmaxf(mx, sv[m]); }
#pragma unroll
        for (int o = 1; o < 32; o <<= 1) mx = fmaxf(mx, __shfl_xor(mx, o));
        const float sink = F.sinks[4 * kvh + (qr & 3)];
        mx = fmaxf(mx, sink);
        float sum = 0.f;
#pragma unroll
        for (int m = 0; m < 5; ++m) { sv[m] = __expf(sv[m] - mx); sum += sv[m]; }
#pragma unroll
        for (int o = 1; o < 32; o <<= 1) sum += __shfl_xor(sum, o);
        const float inv = 1.0f / (sum + __expf(sink - mx));
#pragma unroll
        for (int m = 0; m < 5; ++m) { const int j = l32 + 32 * m; if (j < 132) P[qr * 136 + j] = sv[m] * inv; }
    }
    __syncthreads();
    {
        const int qr = tid >> 5, d2 = (tid & 31) * 2, t = qr >> 2, g = qr & 3;
        float o0 = 0.f, o1 = 0.f;
#pragma unroll 4
        for (int j = 0; j < 132; ++j) { const float p = P[qr * 136 + j]; o0 += p * Vf[j * 64 + d2]; o1 += p * Vf[j * 64 + d2 + 1]; }
        *(unsigned*)(F.SQ + (size_t)(MP + bs * 4 + t) * 512 + (4 * kvh + g) * 64 + d2) = pk2(o0, o1);
    }
    __syncthreads();
}

__device__ __forceinline__ void final_norm(Frame& F) {
    const int gw = F.bid * NWAVES + F.wave, NGW = F.G * NWAVES;
    for (int m = gw; m < M; m += NGW) {
        const float rs = row_rstd(F.SSQ2, m);
        f32x4* xr = (f32x4*)(F.out + (size_t)m * DM) + F.lane; const f32x4* wn = (const f32x4*)F.nf + F.lane;
#pragma unroll
        for (int j = 0; j < 4; ++j) { const f32x4 v = xr[64 * j], wv = wn[64 * j]; xr[64 * j] = (f32x4){v.x * rs * wv.x, v.y * rs * wv.y, v.z * rs * wv.z, v.w * rs * wv.w}; }
    }
}

struct Args { const float* in[17]; float* out; unsigned char* ws; int ph_lo, ph_hi, li, pad; };
__global__ void __launch_bounds__(NWAVES * 64, 2) fwd(Args args) {
    extern __shared__ __attribute__((aligned(16))) unsigned char lds[];
    Frame F;
    F.lds = (LAS unsigned char*)lds;
    F.tid = threadIdx.x; F.lane = F.tid & 63; F.wave = __builtin_amdgcn_readfirstlane(F.tid >> 6); F.G = gridDim.x; F.bid = blockIdx.x;
    unsigned char* ws = args.ws;
    F.xp = args.in[0]; F.xs = args.in[1]; F.ck = args.in[2]; F.cv = args.in[3]; F.st = args.in[4]; F.w_in = args.in[5]; F.lbl = args.in[6]; F.hnw = args.in[7]; F.sinks = args.in[8];
    F.w_ua = args.in[9]; F.w_ub = args.in[10]; F.w_o = args.in[11]; F.n1 = args.in[12]; F.n2 = args.in[13]; F.w_f1 = args.in[14]; F.w_f2 = args.in[15]; F.nf = args.in[16];
    F.out = args.out;
    F.Win_t = (bf16_t*)(ws + WS_WIN); F.Wua_t = (bf16_t*)(ws + WS_WUA); F.Wub_t = (bf16_t*)(ws + WS_WUB); F.Wo_t = (bf16_t*)(ws + WS_WO); F.W1_t = (bf16_t*)(ws + WS_W1); F.W2_t = (bf16_t*)(ws + WS_W2);
    F.LB = (float*)(ws + WS_LB); F.ROT = (f32x2*)(ws + WS_ROT); F.GD = (float*)(ws + WS_GD); F.SSQ1 = (float*)(ws + WS_SSQ1); F.SSQ2 = (float*)(ws + WS_SSQ2); F.LF = (float*)(ws + WS_LF);
    F.XN = (bf16_t*)(ws + WS_XN); F.DS = (bf16_t*)(ws + WS_XN); F.MM = (bf16_t*)(ws + WS_XN); F.X1B = (bf16_t*)(ws + WS_LF);
    F.QH = (bf16_t*)(ws + WS_QH); F.VH = (bf16_t*)(ws + WS_VH); F.GH = (bf16_t*)(ws + WS_GH); F.SQ = (bf16_t*)(ws + WS_SQ); F.SK = (bf16_t*)(ws + WS_SK); F.SV = (bf16_t*)(ws + WS_SV);
    F.GA = (bf16_t*)(ws + WS_GA); F.GB = (bf16_t*)(ws + WS_GB); F.HID = (bf16_t*)(ws + WS_HID);
    for (int u = F.tid; u < (LDS_BYTES - LDSCTL_OFF) / 4; u += NWAVES * 64) ((LAS unsigned*)(F.lds + LDSCTL_OFF))[u] = 0u;
    __syncthreads();
    unsigned* ctl = (unsigned*)(ws + WS_CTL);
    XcdBarrier bar; bar.bar = ctl + CW_BAR; bar.x = 0; bar.st = nullptr;
    if (N_LAUNCHES == 1) bar = xcd_barrier_post(ctl + CW_BAR, (volatile LAS unsigned*)(F.lds + MISC_OFF) + 8);
    const int lo = args.ph_lo, hi = args.ph_hi;
#define IN(k) (lo <= (k) && (k) < hi)
#define SEAM(k) do { if (IN(k) && IN((k) + 1)) xcd_barrier(bar); } while (0)

    if (IN(0)) { p0_prologue(F); }
    SEAM(0);
    if (IN(1)) {
        pg8::Gemm g{F.XN, F.Win_t, F.XN, F.Win_t, DM}; pg8::StaticOrder S; S.init(M, DIN, F.G, F.bid, 0);
        EpiIn E{F.QH, F.VH, F.GH, F.SQ, F.SK, F.SV, F.GA, F.GB, F.LF, F.LB, F.ROT};
        pg8::gemm_phase<EpiIn>(F.lds, g, S, E);
    }
    SEAM(1);
    if (IN(2)) {
        for (int it = F.bid; it < 1024; it += F.G) hgrn_pass1(F, it);
        for (int it = F.bid; it < 256; it += F.G) swa_prompt(F, it);
        for (int it = F.bid; it < 512; it += F.G) hgrn_sample(F, it);
        for (int it = F.bid; it < 256; it += F.G) swa_sample(F, it);
    }
    SEAM(2);
    if (IN(3)) { hgrn_pass2(F); }
    SEAM(3);
    if (IN(4)) { for (int it = F.bid; it < 1024; it += F.G) hgrn_pass3(F, it); }
    SEAM(4);
    if (IN(5)) {
        pg8::Gemm g{F.QH, F.Wua_t, F.SQ, F.Wub_t, 512}; pg8::StaticOrder S; S.init(MP, DM, F.G, F.bid, 1);
        EpiUp E{F.MM, F.GA, F.GB};
        pg8::gemm_phase<EpiUp>(F.lds, g, S, E);
        mini_gemm<64, 2, EpiUp>(F, F.QH, F.Wua_t, F.SQ, F.Wub_t, 512, E);
    }
    SEAM(5);
    if (IN(6)) {
        pg8::Gemm g{F.MM, F.Wo_t, F.MM, F.Wo_t, DM}; pg8::StaticOrder S; S.init(MP, DM, F.G, F.bid, 0);
        EpiWo E{F.xp, F.xs, F.out, F.X1B, F.SSQ1};
        pg8::gemm_phase<EpiWo>(F.lds, g, S, E);
        mini_gemm<64, 1, EpiWo>(F, F.MM, F.Wo_t, F.MM, F.Wo_t, DM, E);
    }
    SEAM(6);
    if (IN(7)) {
        pg8::Gemm g{F.X1B, F.W1_t, F.X1B, F.W1_t, DM}; pg8::StaticOrder S; S.init(MP, DFF, F.G, F.bid, 0);
        EpiFf1 E{F.HID, F.SSQ1};
        pg8::gemm_phase<EpiFf1>(F.lds, g, S, E);
        mini_gemm<256, 1, EpiFf1>(F, F.X1B, F.W1_t, F.X1B, F.W1_t, DM, E);
    }
    SEAM(7);
    if (IN(8)) {
        pg8::Gemm g{F.HID, F.W2_t, F.HID, F.W2_t, DFF}; pg8::StaticOrder S; S.init(MP, DM, F.G, F.bid, 0);
        EpiFf2 E{F.out, F.SSQ2};
        pg8::gemm_phase<EpiFf2>(F.lds, g, S, E);
        mini_gemm<64, 1, EpiFf2>(F, F.HID, F.W2_t, F.HID, F.W2_t, DFF, E);
    }
    SEAM(8);
    if (IN(9)) { final_norm(F); }
#undef IN
#undef SEAM
}

extern "C" void kernel_launch(void* const* d_in, const int* in_sizes, int n_in, void* d_out, int out_size, void* d_ws, size_t ws_size, hipStream_t stream) {
    static int grid = 0;
    if (grid == 0) {
        if (n_in != 17 || in_sizes[0] != MP * DM || ws_size < WS_END) { fprintf(stderr, "kernel_launch: unexpected shapes (n_in %d, in0 %d, ws %zu); nothing launched\n", n_in, n_in > 0 ? in_sizes[0] : -1, ws_size); grid = -1; return; }
        int dev = 0, cus = 0, per_cu = 0;
        if (hipGetDevice(&dev) != hipSuccess || hipDeviceGetAttribute(&cus, hipDeviceAttributeMultiprocessorCount, dev) != hipSuccess) { grid = -1; return; }
        if (hipFuncSetAttribute((const void*)fwd, hipFuncAttributeMaxDynamicSharedMemorySize, LDS_BYTES) != hipSuccess) { fprintf(stderr, "kernel_launch: hipFuncSetAttribute failed\n"); grid = -1; return; }
        if (hipOccupancyMaxActiveBlocksPerMultiprocessor(&per_cu, (const void*)fwd, NWAVES * 64, LDS_BYTES) != hipSuccess || per_cu < 1) { fprintf(stderr, "kernel_launch: occupancy query says %d blocks per CU\n", per_cu); per_cu = 1; }
        (void)hipGetLastError();
        grid = cus;
    }
    if (grid < 0) return;
    (void)hipMemsetAsync((char*)d_ws + WS_CTL, 0, CTL_ZERO_BYTES, stream);
    Args a{};
    for (int i = 0; i < 17; ++i) a.in[i] = (const float*)d_in[i];
    a.out = (float*)d_out; a.ws = (unsigned char*)d_ws;
    if (N_LAUNCHES == 1) {
        a.ph_lo = 0; a.ph_hi = NPHASE; a.li = 0;
        hipLaunchKernelGGL(fwd, dim3(grid), dim3(NWAVES * 64), LDS_BYTES, stream, a);
    } else {
        for (int li = 0; li < NPHASE; ++li) { a.ph_lo = li; a.ph_hi = li + 1; a.li = li; hipLaunchKernelGGL(fwd, dim3(grid), dim3(NWAVES * 64), LDS_BYTES, stream, a); }
    }
}
```
